# Optimizing an MI355X kernel written in HIP

```python
import math
import jax
import jax.numpy as jnp
from jax import lax
import numpy as np

D_MODEL = 2048
BATCH = 2
SEQ = 8192
DEPTH = 2

EPS = 1e-6
NEG = -1e30
FORCE = 1e30
ROPE_THETA = 10000.0

GLA_WIDTH = D_MODEL // 2
GLA_HEADS = 4
GLA_DV = GLA_WIDTH // GLA_HEADS
GLA_DK = GLA_DV // 2
GLA_RANK = 16
GLA_TAU = 16.0
LIN_CHUNK = 64

NSA_DH = 128
NSA_WIDTH = D_MODEL // 2
NSA_HEADS = NSA_WIDTH // NSA_DH
NSA_KV_GROUPS = 2
NSA_HPG = NSA_HEADS // NSA_KV_GROUPS
NSA_KV = NSA_KV_GROUPS * NSA_DH
CMP_LEN = 32
CMP_STRIDE = 16
CMP_HIDDEN = 256
SLC_BLOCK = 64
SLC_TOPK = 16
WINDOW = 512
Q_BLOCK = 128

HGRN_DK = 128
HGRN_WIDTH = D_MODEL // 2
HGRN_HEADS = HGRN_WIDTH // HGRN_DK
HGRN_DV = HGRN_WIDTH // HGRN_HEADS

SSM_HEADDIM = 64
SSM_WIDTH = D_MODEL // 2
SSM_HEADS = SSM_WIDTH // SSM_HEADDIM
SSM_GROUPS = 2
SSM_STATE = 128
SSM_CONV = 4
SSM_CHUNK = 256
SSM_CONV_CH = SSM_WIDTH + 2 * SSM_GROUPS * SSM_STATE

MIX_WIDTH = GLA_WIDTH + NSA_WIDTH

EVEN_SIZES = (GLA_HEADS * GLA_DK, GLA_HEADS * GLA_DK, GLA_WIDTH, GLA_RANK, GLA_WIDTH,
              NSA_WIDTH, NSA_KV, NSA_KV, NSA_KV, NSA_KV, NSA_KV, NSA_KV, NSA_HEADS * 3, NSA_WIDTH)
ODD_SIZES = (HGRN_HEADS * HGRN_DK, HGRN_HEADS * HGRN_DK, HGRN_WIDTH, HGRN_WIDTH,
             SSM_WIDTH, SSM_CONV_CH, SSM_HEADS)

kernel_name = 'hybrid_gla_nsa_hgrn2_ssd_trunk'


def _offsets(sizes):
    return tuple(int(v) for v in np.cumsum(sizes)[:-1])


def rms_norm(x, w):
    xf = x.astype(jnp.float32)
    y = xf * lax.rsqrt(jnp.mean(xf * xf, axis=-1, keepdims=True) + EPS)
    return (y * w.astype(jnp.float32)).astype(x.dtype)


def rope(x, pos):
    half = x.shape[-1] // 2
    inv_freq = ROPE_THETA ** (-jnp.arange(half, dtype=jnp.float32) / half)
    ang = pos.astype(jnp.float32)[:, None] * inv_freq[None, :]
    cos = jnp.cos(ang)[None, :, None, :]
    sin = jnp.sin(ang)[None, :, None, :]
    xf = x.astype(jnp.float32)
    x1, x2 = xf[..., :half], xf[..., half:]
    return jnp.concatenate([x1 * cos - x2 * sin, x1 * sin + x2 * cos], axis=-1).astype(x.dtype)


def chunked_gated_linear_attention(q, k, v, log_g):
    b, s, h, dk = q.shape
    dv = v.shape[-1]
    c = LIN_CHUNK
    n = s // c
    f32 = jnp.float32

    def to_chunks(t):
        return t.astype(f32).reshape(b, n, c, h, t.shape[-1]).transpose(1, 0, 3, 2, 4)

    qc, kc, vc, gc = to_chunks(q), to_chunks(k), to_chunks(v), to_chunks(log_g)
    bc = jnp.cumsum(gc, axis=3)
    causal = jnp.tril(jnp.ones((c, c), dtype=bool))

    def step(state, inp):
        qi, ki, vi, bi = inp
        diff = bi[:, :, :, None, :] - bi[:, :, None, :, :]
        decay = jnp.exp(jnp.where(causal[:, :, None], diff, -jnp.inf))
        attn = jnp.einsum('bhid,bhjd,bhijd->bhij', qi, ki, decay)
        o = (jnp.einsum('bhij,bhjv->bhiv', attn, vi)
             + jnp.einsum('bhid,bhdv->bhiv', qi * jnp.exp(bi), state))
        b_last = bi[:, :, -1:, :]
        k_dec = ki * jnp.exp(b_last - bi)
        state = state * jnp.exp(b_last[:, :, 0, :])[..., None] + jnp.einsum('bhjd,bhjv->bhdv', k_dec, vi)
        return state, o

    s0 = jnp.zeros((b, h, dk, dv), f32)
    _, o = lax.scan(step, s0, (qc, kc, vc, bc))
    return o.transpose(1, 0, 3, 2, 4).reshape(b, s, h, dv)


def gla_branch(q, k, v, g_lr, w_up, b_up, norm_w):
    b, s, _ = q.shape
    q = q.reshape(b, s, GLA_HEADS, GLA_DK) * (GLA_DK ** -0.5)
    k = k.reshape(b, s, GLA_HEADS, GLA_DK)
    v = v.reshape(b, s, GLA_HEADS, GLA_DV)
    log_g = jax.nn.log_sigmoid((g_lr @ w_up + b_up).astype(jnp.float32)) / GLA_TAU
    o = chunked_gated_linear_attention(q, k, v, log_g.reshape(b, s, GLA_HEADS, GLA_DK))
    return rms_norm(o, norm_w).reshape(b, s, GLA_WIDTH)


def nsa_compress(t, pe, w1, w2):
    b, s, g, dh = t.shape
    n_cmp = (s - CMP_LEN) // CMP_STRIDE + 1
    idx = jnp.arange(n_cmp)[:, None] * CMP_STRIDE + jnp.arange(CMP_LEN)[None, :]
    blocks = t[:, idx] + pe[None, None, :, None, :]
    flat = blocks.transpose(0, 1, 3, 2, 4).reshape(b, n_cmp, g, CMP_LEN * dh)
    return jax.nn.silu(flat @ w1) @ w2


def nsa_branch(q, k_cmp, v_cmp, k_slc, v_slc, k_win, v_win, gate_raw,
               pe_k, w1_k, w2_k, pe_v, w1_v, w2_v):
    b, s, _ = q.shape
    f32 = jnp.float32
    g_, j_, dh = NSA_KV_GROUPS, NSA_HPG, NSA_DH
    pos = jnp.arange(s)
    q = rope(q.reshape(b, s, NSA_HEADS, dh), pos) * (dh ** -0.5)
    q = q.reshape(b, s, g_, j_, dh)
    kc = nsa_compress(rope(k_cmp.reshape(b, s, g_, dh), pos), pe_k, w1_k, w2_k)
    vc = nsa_compress(v_cmp.reshape(b, s, g_, dh), pe_v, w1_v, w2_v)
    n_cmp = kc.shape[1]
    n_slc = s // SLC_BLOCK
    n_sel = min(SLC_TOPK, n_slc)
    ks_blocks = rope(k_slc.reshape(b, s, g_, dh), pos).reshape(b, n_slc, SLC_BLOCK, g_, dh).transpose(0, 3, 1, 2, 4)
    vs_blocks = v_slc.reshape(b, n_slc, SLC_BLOCK, g_, dh).transpose(0, 3, 1, 2, 4)
    kw_pad = jnp.pad(rope(k_win.reshape(b, s, g_, dh), pos), ((0, 0), (WINDOW, 0), (0, 0), (0, 0)))
    vw_pad = jnp.pad(v_win.reshape(b, s, g_, dh), ((0, 0), (WINDOW, 0), (0, 0), (0, 0)))
    gates = jax.nn.sigmoid(gate_raw.astype(f32)).reshape(b, s, g_, j_, 3)

    cmp_start = jnp.arange(n_cmp) * CMP_STRIDE
    cmp_end = cmp_start + CMP_LEN - 1
    sblk = jnp.arange(n_slc)
    slc_start = sblk * SLC_BLOCK
    overlap = (jnp.minimum(cmp_start[:, None] + CMP_LEN, slc_start[None, :] + SLC_BLOCK)
               - jnp.maximum(cmp_start[:, None], slc_start[None, :]))
    cmp_to_slc = (overlap > 0).astype(f32)
    gather = jax.vmap(jax.vmap(lambda kb, ib: kb[ib]))

    def block(qb):
        t0 = qb * Q_BLOCK
        t = t0 + jnp.arange(Q_BLOCK)
        qblk = lax.dynamic_slice_in_dim(q, t0, Q_BLOCK, axis=1)
        s1 = jnp.einsum('bqgjd,bngd->bgjqn', qblk, kc).astype(f32)
        m1 = cmp_end[None, :] <= t[:, None]
        p1 = jax.nn.softmax(jnp.where(m1, s1, NEG), axis=-1) * m1
        o_c = jnp.einsum('bgjqn,bngd->bqgjd', p1, vc)
        imp = jnp.einsum('bgjqn,ns->bgqs', p1, cmp_to_slc)
        blk_t = t // SLC_BLOCK
        causal_blk = sblk[None, :] <= blk_t[:, None]
        forced = (sblk[None, :] == 0) | (sblk[None, :] == blk_t[:, None]) | (sblk[None, :] == blk_t[:, None] - 1)
        score = jnp.where(forced, FORCE, jnp.where(causal_blk, imp, NEG))
        _, idx = lax.top_k(score, n_sel)
        k_sel = gather(ks_blocks, idx)
        v_sel = gather(vs_blocks, idx)
        tok = idx[..., None] * SLC_BLOCK + jnp.arange(SLC_BLOCK)
        m2 = tok <= t[None, None, :, None, None]
        s2 = jnp.einsum('bqgjd,bgqkld->bgjqkl', qblk, k_sel).astype(f32)
        s2 = jnp.where(m2[:, :, None], s2, NEG).reshape(b, g_, j_, Q_BLOCK, n_sel * SLC_BLOCK)
        p2 = jax.nn.softmax(s2, axis=-1).reshape(b, g_, j_, Q_BLOCK, n_sel, SLC_BLOCK)
        o_s = jnp.einsum('bgjqkl,bgqkld->bqgjd', p2, v_sel)
        kw = lax.dynamic_slice_in_dim(kw_pad, t0, Q_BLOCK + WINDOW, axis=1)
        vw = lax.dynamic_slice_in_dim(vw_pad, t0, Q_BLOCK + WINDOW, axis=1)
        kpos = t0 - WINDOW + jnp.arange(Q_BLOCK + WINDOW)
        m3 = (kpos[None, :] <= t[:, None]) & (kpos[None, :] > t[:, None] - WINDOW) & (kpos[None, :] >= 0)
        s3 = jnp.einsum('bqgjd,bkgd->bgjqk', qblk, kw).astype(f32)
        p3 = jax.nn.softmax(jnp.where(m3, s3, NEG), axis=-1)
        o_w = jnp.einsum('bgjqk,bkgd->bqgjd', p3, vw)
        gb = lax.dynamic_slice_in_dim(gates, t0, Q_BLOCK, axis=1)
        return gb[..., 0:1] * o_c + gb[..., 1:2] * o_s + gb[..., 2:3] * o_w

    out = lax.map(block, jnp.arange(s // Q_BLOCK))
    return out.transpose(1, 0, 2, 3, 4, 5).reshape(b, s, NSA_WIDTH)


def hgrn2_branch(q, f_raw, i, lb, norm_w):
    b, s, _ = q.shape
    q = q.reshape(b, s, HGRN_HEADS, HGRN_DK)
    z = f_raw.astype(jnp.float32).reshape(b, s, HGRN_HEADS, HGRN_DK)
    i = i.reshape(b, s, HGRN_HEADS, HGRN_DV)
    lb = lb.reshape(HGRN_HEADS, HGRN_DK)
    log_f = jnp.logaddexp(jnp.log(lb), jnp.log1p(-lb) + jax.nn.log_sigmoid(z))
    k = (1.0 - lb) * jax.nn.sigmoid(-z)
    o = chunked_gated_linear_attention(q, k, i, log_f)
    return rms_norm(o, norm_w).reshape(b, s, HGRN_WIDTH)


def causal_depthwise_conv(x, w, bias):
    ch = x.shape[-1]
    y = lax.conv_general_dilated(x, w[:, None, :], window_strides=(1,), padding=((SSM_CONV - 1, 0),),
                                 dimension_numbers=('NWC', 'WIO', 'NWC'), feature_group_count=ch)
    return y + bias


def segsum(a):
    t = a.shape[-1]
    cs = jnp.cumsum(a, axis=-1)
    d = cs[..., :, None] - cs[..., None, :]
    return jnp.where(jnp.tril(jnp.ones((t, t), dtype=bool)), d, -jnp.inf)


def ssd_chunked_scan(xdt, da, bm, cm):
    b, s, h, p = xdt.shape
    n = bm.shape[-1]
    c = math.gcd(SSM_CHUNK, s)
    nc = s // c
    x = xdt.reshape(b, nc, c, h, p)
    bm = bm.reshape(b, nc, c, h, n)
    cm = cm.reshape(b, nc, c, h, n)
    a = da.reshape(b, nc, c, h).transpose(0, 1, 3, 2)
    a_cs = jnp.cumsum(a, axis=-1)
    lmat = jnp.exp(segsum(a))
    cb = jnp.einsum('bclhn,bcshn->bchls', cm, bm)
    y_diag = jnp.einsum('bchls,bcshp->bclhp', cb * lmat, x)
    decay_states = jnp.exp(a_cs[..., -1:] - a_cs).transpose(0, 1, 3, 2)[..., None]
    states = jnp.einsum('bclhn,bclhp->bchpn', bm, x * decay_states)
    states = jnp.concatenate([jnp.zeros_like(states[:, :1]), states], axis=1)
    chunk_end = jnp.pad(a_cs[..., -1].transpose(0, 2, 1), ((0, 0), (0, 0), (1, 0)))
    chunk_decay = jnp.exp(segsum(chunk_end))
    prev = jnp.einsum('bhzc,bchpn->bzhpn', chunk_decay, states)[:, :-1]
    y_off = jnp.einsum('bclhn,bchpn->bclhp', cm, prev) * jnp.exp(a_cs).transpose(0, 1, 3, 2)[..., None]
    return (y_diag + y_off).reshape(b, s, h, p)


def mamba2_branch(xbc, dt_raw, conv_w, conv_b, dt_bias, a_log, d_skip):
    b, s, _ = xbc.shape
    f32 = jnp.float32
    xbc = jax.nn.silu(causal_depthwise_conv(xbc, conv_w, conv_b))
    xs, bm, cm = jnp.split(xbc, (SSM_WIDTH, SSM_WIDTH + SSM_GROUPS * SSM_STATE), axis=-1)
    rep = SSM_HEADS // SSM_GROUPS
    xs = xs.reshape(b, s, SSM_HEADS, SSM_HEADDIM).astype(f32)
    bm = jnp.repeat(bm.reshape(b, s, SSM_GROUPS, SSM_STATE), rep, axis=2).astype(f32)
    cm = jnp.repeat(cm.reshape(b, s, SSM_GROUPS, SSM_STATE), rep, axis=2).astype(f32)
    dt = jax.nn.softplus(dt_raw.astype(f32) + dt_bias.astype(f32))
    a = -jnp.exp(a_log.astype(f32))
    y = ssd_chunked_scan(xs * dt[..., None], dt * a, bm, cm)
    y = y + d_skip.astype(f32)[:, None] * xs
    return y.reshape(b, s, SSM_WIDTH)


def even_mixer(h, w_in, w_out, gla_w_up, gla_b_up, gla_norm_w,
               pe_k, w1_k, w2_k, pe_v, w1_v, w2_v):
    proj = h @ w_in
    (gq, gk, gv, glr, gz, nq, nkc, nvc, nks, nvs, nkw, nvw, ngate, nz) = jnp.split(proj, _offsets(EVEN_SIZES), axis=-1)
    o_gla = gla_branch(gq, gk, gv, glr, gla_w_up, gla_b_up, gla_norm_w).astype(h.dtype) * jax.nn.silu(gz)
    o_nsa = nsa_branch(nq, nkc, nvc, nks, nvs, nkw, nvw, ngate,
                       pe_k, w1_k, w2_k, pe_v, w1_v, w2_v).astype(h.dtype) * jax.nn.silu(nz)
    return jnp.concatenate([o_gla, o_nsa], axis=-1) @ w_out


def odd_mixer(h, lb, w_in, w_out, hgrn_norm_w, conv_w, conv_b, dt_bias, a_log, d_skip, ssm_norm_w):
    proj = h @ w_in
    hq, hf, hi, hz, sz, sxbc, sdt = jnp.split(proj, _offsets(ODD_SIZES), axis=-1)
    o_h = hgrn2_branch(hq, hf, hi, lb, hgrn_norm_w).astype(h.dtype) * jax.nn.silu(hz)
    y = mamba2_branch(sxbc, sdt, conv_w, conv_b, dt_bias, a_log, d_skip)
    o_s = rms_norm(y * jax.nn.silu(sz.astype(jnp.float32)), ssm_norm_w).astype(h.dtype)
    return jnp.concatenate([o_h, o_s], axis=-1) @ w_out


def setup_inputs(seed: int = 0) -> dict:
    key = jax.random.key(seed)
    keys = iter(jax.random.split(key, 40))
    f32 = jnp.float32
    ne, no = (DEPTH + 1) // 2, DEPTH // 2

    def nrm(shape, scale):
        return jax.random.normal(next(keys), shape, f32) * scale

    def gain(shape):
        return 1.0 + nrm(shape, 0.01)

    dt0 = jnp.exp(jax.random.uniform(next(keys), (no, SSM_HEADS), f32, math.log(1e-3), math.log(1e-1)))
    dt_bias = dt0 + jnp.log(-jnp.expm1(-dt0))
    a_log = jnp.log(jax.random.uniform(next(keys), (no, SSM_HEADS), f32, 1.0, 16.0))
    return {
        'x': nrm((BATCH, SEQ, D_MODEL), 1.0),
        'c': nrm((BATCH, D_MODEL), 1.0),
        'ada_w': nrm((DEPTH, D_MODEL, 3 * D_MODEL), 0.5 * D_MODEL ** -0.5),
        'ada_b': nrm((DEPTH, 3 * D_MODEL), 0.01),
        'pre_norm_w': gain((DEPTH, D_MODEL)),
        'post_norm_w': gain((DEPTH, D_MODEL)),
        'even_w_in': nrm((ne, D_MODEL, sum(EVEN_SIZES)), D_MODEL ** -0.5),
        'even_w_out': nrm((ne, MIX_WIDTH, D_MODEL), MIX_WIDTH ** -0.5),
        'gla_w_up': nrm((ne, GLA_RANK, GLA_HEADS * GLA_DK), GLA_RANK ** -0.5),
        'gla_b_up': nrm((ne, GLA_HEADS * GLA_DK), 0.1),
        'gla_norm_w': gain((ne, GLA_DV)),
        'nsa_pe_k': nrm((ne, CMP_LEN, NSA_DH), 0.02),
        'nsa_w1_k': nrm((ne, CMP_LEN * NSA_DH, CMP_HIDDEN), (CMP_LEN * NSA_DH) ** -0.5),
        'nsa_w2_k': nrm((ne, CMP_HIDDEN, NSA_DH), CMP_HIDDEN ** -0.5),
        'nsa_pe_v': nrm((ne, CMP_LEN, NSA_DH), 0.02),
        'nsa_w1_v': nrm((ne, CMP_LEN * NSA_DH, CMP_HIDDEN), (CMP_LEN * NSA_DH) ** -0.5),
        'nsa_w2_v': nrm((ne, CMP_HIDDEN, NSA_DH), CMP_HIDDEN ** -0.5),
        'odd_w_in': nrm((no, D_MODEL, sum(ODD_SIZES)), D_MODEL ** -0.5),
        'odd_w_out': nrm((no, MIX_WIDTH, D_MODEL), MIX_WIDTH ** -0.5),
        'hgrn_lb_logits': nrm((DEPTH, HGRN_HEADS * HGRN_DK), 0.1),
        'hgrn_norm_w': gain((no, HGRN_DV)),
        'ssm_conv_w': nrm((no, SSM_CONV, SSM_CONV_CH), SSM_CONV ** -0.5),
        'ssm_conv_b': nrm((no, SSM_CONV_CH), 0.01),
        'ssm_dt_bias': dt_bias,
        'ssm_a_log': a_log,
        'ssm_d': gain((no, SSM_HEADS)),
        'ssm_norm_w': gain((no, SSM_WIDTH)),
    }


def reference(x, c, ada_w, ada_b, pre_norm_w, post_norm_w,
              even_w_in, even_w_out, gla_w_up, gla_b_up, gla_norm_w,
              nsa_pe_k, nsa_w1_k, nsa_w2_k, nsa_pe_v, nsa_w1_v, nsa_w2_v,
              odd_w_in, odd_w_out, hgrn_lb_logits, hgrn_norm_w,
              ssm_conv_w, ssm_conv_b, ssm_dt_bias, ssm_a_log, ssm_d, ssm_norm_w):
    sm = jax.nn.softmax(hgrn_lb_logits.astype(jnp.float32), axis=0)
    lb_all = jnp.cumsum(sm, axis=0) - sm[0]
    c_act = jax.nn.silu(c)
    for l in range(DEPTH):
        mod = c_act @ ada_w[l] + ada_b[l]
        shift, scale, gate = jnp.split(mod, 3, axis=-1)
        h = rms_norm(x, pre_norm_w[l]) * (1.0 + scale[:, None, :]) + shift[:, None, :]
        if l % 2 == 0:
            e = l // 2
            y = even_mixer(h, even_w_in[e], even_w_out[e], gla_w_up[e], gla_b_up[e], gla_norm_w[e],
                           nsa_pe_k[e], nsa_w1_k[e], nsa_w2_k[e], nsa_pe_v[e], nsa_w1_v[e], nsa_w2_v[e])
        else:
            o = l // 2
            y = odd_mixer(h, lb_all[l], odd_w_in[o], odd_w_out[o], hgrn_norm_w[o], ssm_conv_w[o], ssm_conv_b[o],
                          ssm_dt_bias[o], ssm_a_log[o], ssm_d[o], ssm_norm_w[o])
        x = x + gate[:, None, :] * rms_norm(y, post_norm_w[l])
    return x
```

```cpp
#include <hip/hip_runtime.h>
#include <cstdio>
#include <cstdint>

#define GAS __attribute__((address_space(1)))
#define LAS __attribute__((address_space(3)))
#define DI __device__ __forceinline__
typedef unsigned short bf16_t;
typedef short bf16x8 __attribute__((ext_vector_type(8)));
typedef short s16x4 __attribute__((ext_vector_type(4)));
typedef float f32x2 __attribute__((ext_vector_type(2)));
typedef float f32x4 __attribute__((ext_vector_type(4)));
typedef float f32x16 __attribute__((ext_vector_type(16)));
typedef unsigned u32x2 __attribute__((ext_vector_type(2)));
typedef unsigned u32x4 __attribute__((ext_vector_type(4)));
typedef __bf16 bf16x2_t __attribute__((ext_vector_type(2)));

DI unsigned f2bf(float f) { unsigned u = __builtin_bit_cast(unsigned, f); return (u + 0x7fffu + ((u >> 16) & 1u)) >> 16; }
DI float bf2f(unsigned short h) { return __builtin_bit_cast(float, (unsigned)h << 16); }
DI unsigned pk2(float lo, float hi) { f32x2 v = {lo, hi}; bf16x2_t b = __builtin_convertvector(v, bf16x2_t); return __builtin_bit_cast(unsigned, b); }
DI float bflo(unsigned w) { return __builtin_bit_cast(float, w << 16); }
DI float bfhi(unsigned w) { return __builtin_bit_cast(float, w & 0xffff0000u); }
DI float fast_exp2(float x) { return __builtin_amdgcn_exp2f(x); }
DI float sigmoidf_(float x) { return 1.f / (1.f + __expf(-x)); }
DI float siluf_(float x) { return x / (1.f + __expf(-x)); }
DI int crow(int reg, int h) { return (reg & 3) + 8 * (reg >> 2) + 4 * h; }
#define MFMA32(a, b, c) __builtin_amdgcn_mfma_f32_32x32x16_bf16((a), (b), (c), 0, 0, 0)

constexpr int BATCH = 2, SEQ = 8192, DM = 2048, MTOK = BATCH * SEQ;
constexpr int N_EVEN = 6696, N_ODD = 6672;
constexpr float EPS = 1e-6f;
constexpr float LOG2E = 1.4426950408889634f;

namespace pg8 {
constexpr int BM = 256, BK = 64, HALF = 128, HTB = HALF * BK * 2, STAGE_BYTES = 8 * HTB, NXCD = 8, WGM = 8;
__host__ __device__ __forceinline__ int lds_byte(int r, int c) { const int st = (r >> 4) * 2 + (c >> 5), rr = r & 15, cc = c & 31, ob = rr * 64 + cc * 2; return st * 1024 + (ob ^ (((ob >> 9) & 1) << 5)); }
__host__ __device__ __forceinline__ void stage_rc(int b, int& R, int& C) { const int st = b / 1024, sb = b % 1024, swz = sb ^ (((sb >> 9) & 1) << 5); R = (st >> 1) * 16 + swz / 64; C = (st & 1) * 32 + (swz % 64) / 2; }
__host__ __device__ __forceinline__ int perm32(int rho) { const int n = rho >> 4, i = rho & 15; return 8 * (i >> 2) + 4 * n + (i & 3); }

struct Unit { int pm, pn, job, ks; };
struct Gemm { const bf16_t* A[2]; const bf16_t* Bt[2]; int nM[2], nN[2], nK[2]; int lda, ldb, Klen; int chain; };

struct MultiOrder {
    int n0, n1, G, c; int nM0, nN0, nK0, nM1, nN1, nK1, chain;
    __device__ __forceinline__ void init(const Gemm& g, int G_, int c_) { nM0 = g.nM[0]; nN0 = g.nN[0]; nK0 = g.nK[0]; nM1 = g.nM[1]; nN1 = g.nN[1]; nK1 = g.nK[1]; n0 = nM0 * nN0 * nK0; n1 = nM1 * nN1 * nK1; G = G_; c = c_; chain = g.chain; }
    __device__ __forceinline__ static void tile(int wgid, int nM, int nN, int nK, Unit& u) {
        if (nK > 1) { u.ks = wgid % nK; wgid /= nK; u.pn = wgid % nN; u.pm = wgid / nN; return; }
        u.ks = 0; const int nwg = nM * nN;
        { const int q = nwg / NXCD, r = nwg % NXCD, xcd = wgid % NXCD, off = wgid / NXCD; wgid = (xcd < r ? xcd * (q + 1) : r * (q + 1) + (xcd - r) * q) + off; }
        const int nig = WGM * nN, gid = wgid / nig, fm = gid * WGM, gsz = (nM - fm) < WGM ? (nM - fm) : WGM;
        u.pm = fm + ((wgid % nig) % gsz); u.pn = (wgid % nig) / gsz;
    }
    __device__ __forceinline__ bool next(int i, Unit& u) const {
        if (chain) { const long T = (long)(i / nK0) * G + c; if (T >= nM0 * nN0) return false; u.job = 0; tile((int)T, nM0, nN0, 1, u); u.ks = i % nK0; return true; }
        const long L = (long)i * G + c; if (L >= n0 + n1) return false;
        if (L < n0) { u.job = 0; tile((int)L, nM0, nN0, nK0, u); } else { u.job = 1; tile((int)L - n0, nM1, nN1, nK1, u); }
        return true;
    }
};

template <class Epi>
__device__ __forceinline__ void gemm_phase(LAS unsigned char* lds, const Gemm& g, const MultiOrder& S, const Epi& E) {
    static_assert(Epi::PERM, "this copy keeps only the PERM = true staging");
    const int tid = threadIdx.x, wid = __builtin_amdgcn_readfirstlane(tid >> 6), lane = tid & 63, wr = wid >> 2, wc = wid & 3, fr = lane & 15, fq = lane >> 4;
    const int nt = g.Klen / BK;
    unsigned voffA[2], voffB[2];
#pragma unroll
    for (int i = 0; i < 2; ++i) { int R, C; stage_rc(tid * 16 + i * 8192, R, C); const int Rb = (R & ~31) + perm32(R & 31);
        voffA[i] = (unsigned)(R * g.lda + C) * 2u; voffB[i] = (unsigned)(Rb * g.ldb + C) * 2u; }
    const size_t kstep = (size_t)(BK * 2);
    const size_t hstepA = (size_t)HALF * g.lda * 2, hstepB = (size_t)HALF * g.ldb * 2;
    const unsigned ldsw = (unsigned)wid * 1024u;
    const int aoff = lds_byte(wr * 64 + fr, fq * 8), boff = lds_byte(wc * 32 + fr, fq * 8);
#define PG8_SA(b, h) (((b) * 2 + (h)) * HTB)
#define PG8_SB(b, h) ((4 + (b) * 2 + (h)) * HTB)
#define PG8_STAGE(bufoff, gbase, voff) do { _Pragma("unroll") for (int _i = 0; _i < 2; ++_i) \
        __builtin_amdgcn_global_load_lds((const unsigned*)((const char*)(gbase) + (voff)[_i]), (LAS unsigned*)(lds + (bufoff) + ldsw + _i * 8192), 16, 0, 0); } while (0)
#define PG8_LDA(dst, b, h) do { _Pragma("unroll") for (int m = 0; m < 4; ++m) _Pragma("unroll") for (int k = 0; k < 2; ++k) dst[m][k] = *(const LAS bf16x8*)(lds + PG8_SA(b, h) + aoff + m * 2048 + k * 1024); } while (0)
#define PG8_LDB(dst, b, h) do { _Pragma("unroll") for (int n = 0; n < 2; ++n) _Pragma("unroll") for (int k = 0; k < 2; ++k) dst[n][k] = *(const LAS bf16x8*)(lds + PG8_SB(b, h) + boff + n * 2048 + k * 1024); } while (0)
#define PG8_MMA(ai, bj, At, Bt) do { __builtin_amdgcn_s_setprio(1); _Pragma("unroll") for (int m = 0; m < 4; ++m) _Pragma("unroll") for (int n = 0; n < 2; ++n) _Pragma("unroll") for (int k = 0; k < 2; ++k) \
        acc[ai][bj][m][n] = __builtin_amdgcn_mfma_f32_16x16x32_bf16(Bt[n][k], At[m][k], acc[ai][bj][m][n], 0, 0, 0); __builtin_amdgcn_s_setprio(0); } while (0)
#define PG8_WAIT_V(n) asm volatile("s_waitcnt vmcnt(" #n ")" ::: "memory")
#define PG8_WAIT_L(n) asm volatile("s_waitcnt lgkmcnt(" #n ")" ::: "memory")
#define PG8_BAR __builtin_amdgcn_s_barrier()
#define PG8_SCHED __builtin_amdgcn_sched_barrier(0)
#define PG8_UA(u) ((const char*)((u).job ? g.A[1] : g.A[0]) + ((size_t)(u).pm * BM * g.lda + (size_t)(u).ks * g.Klen) * 2)
#define PG8_UB(u) ((const char*)((u).job ? g.Bt[1] : g.Bt[0]) + ((size_t)(u).pn * BM * g.ldb + (size_t)(u).ks * g.Klen) * 2)
    Unit cur, nxt; int ui = 0;
    if (!S.next(0, cur)) return;
    f32x4 acc[2][2][4][2];
#pragma unroll
    for (int a = 0; a < 2; ++a)
#pragma unroll
        for (int b = 0; b < 2; ++b)
#pragma unroll
            for (int m = 0; m < 4; ++m)
#pragma unroll
                for (int n = 0; n < 2; ++n) acc[a][b][m][n] = (f32x4){0.f, 0.f, 0.f, 0.f};
    bf16x8 At[4][2], B0[2][2], B1[2][2];
    const char* cA = PG8_UA(cur); const char* cB = PG8_UB(cur);
    PG8_STAGE(PG8_SB(0, 0), cB, voffB); PG8_STAGE(PG8_SB(0, 1), cB + hstepB, voffB); PG8_STAGE(PG8_SA(0, 0), cA, voffA); PG8_STAGE(PG8_SA(0, 1), cA + hstepA, voffA);
    if (wr == 1) PG8_BAR;
    PG8_WAIT_V(2); PG8_BAR;
    PG8_STAGE(PG8_SB(1, 0), cB + kstep, voffB); PG8_STAGE(PG8_SA(1, 0), cA + kstep, voffA); PG8_STAGE(PG8_SB(1, 1), cB + hstepB + kstep, voffB);
    PG8_WAIT_V(6); PG8_BAR;
    for (;;) {
        const bool has_next = S.next(ui + 1, nxt);
        const char* nA = has_next ? PG8_UA(nxt) : cA; const char* nB = has_next ? PG8_UB(nxt) : cB;
        for (int t = 0; t < nt; t += 2) {
            const bool last = (t == nt - 2);
            const char* a1 = cA + (size_t)(t + 1) * kstep;
            const char* a2 = last ? nA : cA + (size_t)(t + 2) * kstep; const char* b2 = last ? nB : cB + (size_t)(t + 2) * kstep;
            const char* a3 = a2 + kstep; const char* b3 = b2 + kstep;
            PG8_LDB(B0, 0, 0); PG8_LDB(B1, 0, 1); PG8_SCHED; PG8_LDA(At, 0, 0); PG8_STAGE(PG8_SA(1, 1), a1 + hstepA, voffA);
            PG8_WAIT_V(8); PG8_WAIT_L(0); PG8_BAR; PG8_MMA(0, 0, At, B0); PG8_MMA(0, 1, At, B1); PG8_BAR; PG8_SCHED;
            PG8_LDA(At, 0, 1); PG8_STAGE(PG8_SB(0, 0), b2, voffB); PG8_STAGE(PG8_SB(0, 1), b2 + hstepB, voffB); PG8_STAGE(PG8_SA(0, 0), a2, voffA);
            PG8_WAIT_V(8); PG8_WAIT_L(0); PG8_BAR; PG8_MMA(1, 0, At, B0); PG8_MMA(1, 1, At, B1); PG8_BAR; PG8_SCHED;
            PG8_LDB(B0, 1, 0); PG8_LDB(B1, 1, 1); PG8_SCHED; PG8_LDA(At, 1, 0); PG8_STAGE(PG8_SA(0, 1), a2 + hstepA, voffA);
            PG8_WAIT_V(8); PG8_WAIT_L(0); PG8_BAR; PG8_MMA(0, 0, At, B0); PG8_MMA(0, 1, At, B1); PG8_BAR; PG8_SCHED;
            PG8_LDA(At, 1, 1); PG8_STAGE(PG8_SB(1, 0), b3, voffB); PG8_STAGE(PG8_SB(1, 1), b3 + hstepB, voffB); PG8_STAGE(PG8_SA(1, 0), a3, voffA);
            PG8_WAIT_V(8); PG8_WAIT_L(0); PG8_BAR; PG8_MMA(1, 0, At, B0); PG8_MMA(1, 1, At, B1); PG8_BAR; PG8_SCHED;
        }
        if (wr == 0) PG8_BAR;
        const bool keep = E(acc, cur, wr, wc, fr, fq);
        if (!has_next) break;
        if (!keep) {
#pragma unroll
            for (int a = 0; a < 2; ++a)
#pragma unroll
                for (int b = 0; b < 2; ++b)
#pragma unroll
                    for (int m = 0; m < 4; ++m)
#pragma unroll
                        for (int n = 0; n < 2; ++n) acc[a][b][m][n] = (f32x4){0.f, 0.f, 0.f, 0.f};
        }
        cur = nxt; cA = nA; cB = nB; ++ui;
        if (wr == 1) PG8_BAR;
    }
    PG8_WAIT_V(0);
    PG8_BAR;
#undef PG8_SA
#undef PG8_SB
#undef PG8_STAGE
#undef PG8_LDA
#undef PG8_LDB
#undef PG8_MMA
#undef PG8_WAIT_V
#undef PG8_WAIT_L
#undef PG8_BAR
#undef PG8_SCHED
#undef PG8_UA
#undef PG8_UB
}
}
#define XB_TMO      128
#define XB_XCNT(j)  (256  + 64 * (j))
#define XB_XSUB(j)  (1280 + 64 * (j))
#define XB_XGEN(j)  (2304 + 64 * (j))
#define XB_TOP      3328
#define XB_TOPGEN   3392
#define XCD_BAR_WORDS 3456
#define XB_SPIN_CAP (1u << 24)
DI unsigned xb_ld(unsigned* p)              { return __hip_atomic_load(p, __ATOMIC_RELAXED, __HIP_MEMORY_SCOPE_AGENT); }
DI unsigned xb_add(unsigned* p, unsigned v) { return __hip_atomic_fetch_add(p, v, __ATOMIC_RELAXED, __HIP_MEMORY_SCOPE_AGENT); }
DI unsigned xb_xcc_id() { return (unsigned)__builtin_amdgcn_s_getreg((3 << 11) | 20) & 0xFu; }
#define XB_SPIN(cond, bar) do { unsigned _sp = 0; while (cond) { __builtin_amdgcn_s_sleep(1); \
    if ((++_sp & 255u) == 0u) { if (xb_ld(&(bar)[XB_TMO])) break; if (_sp > XB_SPIN_CAP) { atomicAdd(&(bar)[XB_TMO], 1u); break; } } } } while (0)
struct XcdBarrier { unsigned* bar; unsigned x; volatile LAS unsigned* st; };
DI XcdBarrier xcd_barrier_post(unsigned* bar, volatile LAS unsigned* st) {
    XcdBarrier b; b.bar = bar; b.x = xb_xcc_id(); b.st = st;
    if (threadIdx.x == 0) (void)xb_add(&bar[XB_XCNT(b.x)], 1u);
    return b;
}
DI void xcd_barrier_complete(unsigned* bar, unsigned x, unsigned& nloc, unsigned& nx) {
    const unsigned G = gridDim.x * gridDim.y * gridDim.z;
    unsigned sum, cnt, mine, sp = 0u;
    for (;;) {
        sum = 0u; cnt = 0u; mine = 0u;
#pragma unroll
        for (unsigned j = 0; j < 16; ++j) { const unsigned c = xb_ld(&bar[XB_XCNT(j)]); sum += c; cnt += (c > 0u) ? 1u : 0u; mine = (j == x) ? c : mine; }
        if (sum == G) break;
        __builtin_amdgcn_s_sleep(1);
        if ((++sp & 255u) == 0u) { if (xb_ld(&bar[XB_TMO])) break; if (sp > XB_SPIN_CAP) { atomicAdd(&bar[XB_TMO], 1u); break; } }
    }
    nloc = mine > 0u ? mine : 1u; nx = cnt > 0u ? cnt : 1u;
}
DI void xcd_barrier(const XcdBarrier& b) {
    asm volatile("s_waitcnt vmcnt(0)" ::: "memory");
    __syncthreads();
    if (threadIdx.x == 0) {
        unsigned* bar = b.bar;
        __builtin_amdgcn_s_waitcnt(0);
        unsigned nloc = b.st[0], nx = b.st[1];
        if (nloc == 0u) { xcd_barrier_complete(bar, b.x, nloc, nx); b.st[0] = nloc; b.st[1] = nx; }
        const unsigned old = xb_add(&bar[XB_XSUB(b.x)], 1u);
        const unsigned gen = old / nloc;
        if (old + 1u == (gen + 1u) * nloc) {
            __builtin_amdgcn_fence(__ATOMIC_RELEASE, "agent");
            asm volatile("s_waitcnt vmcnt(0)" ::: "memory");
            const unsigned og = xb_add(&bar[XB_TOP], 1u);
            const unsigned tg = og / nx;
            if (og + 1u == (tg + 1u) * nx) xb_add(&bar[XB_TOPGEN], 1u);
            else XB_SPIN(xb_ld(&bar[XB_TOPGEN]) == tg, bar);
            __builtin_amdgcn_fence(__ATOMIC_ACQUIRE, "agent");
            xb_add(&bar[XB_XGEN(b.x)], 1u);
            asm volatile("s_waitcnt vmcnt(0)" ::: "memory");
        } else {
            XB_SPIN(xb_ld(&bar[XB_XGEN(b.x)]) == gen, bar);
            __builtin_amdgcn_fence(__ATOMIC_ACQUIRE, "agent");
            asm volatile("s_waitcnt vmcnt(0)" ::: "memory");
        }
    }
    __syncthreads();
}

constexpr size_t MiB = 1u << 20;
constexpr size_t WS_CTL = 0, CTL_ZERO_BYTES = 64 * 1024;
constexpr int NN0 = 5376, NT0 = 1536, NN1 = 4864, NT1 = 2048;
constexpr size_t WS_WN0 = 1 * MiB;
constexpr size_t WS_WT0 = WS_WN0 + (size_t)NN0 * DM * 2;
constexpr size_t WS_WO0 = WS_WT0 + (size_t)NT0 * DM * 2;
constexpr size_t WS_W1K = WS_WO0 + (size_t)DM * DM * 2;
constexpr size_t WS_W1V = WS_W1K + (size_t)256 * 4096 * 2;
constexpr size_t WS_WN1 = WS_W1V + (size_t)256 * 4096 * 2;
constexpr size_t WS_WT1 = WS_WN1 + (size_t)NN1 * DM * 2;
constexpr size_t WS_WO1 = WS_WT1 + (size_t)NT1 * DM * 2;
constexpr size_t WS_WEND = WS_WO1 + (size_t)DM * DM * 2;
constexpr size_t WS_BL   = 75 * MiB;
static_assert(WS_WEND <= WS_BL && WS_BL + 2 * MiB <= 78 * MiB, "weights");
constexpr size_t WS_SMALL = 78 * MiB;
constexpr size_t WS_MOD   = WS_SMALL;
constexpr size_t WS_ROPE  = WS_SMALL + 1 * MiB;
constexpr size_t WS_LB    = WS_SMALL + 5 * MiB;
constexpr size_t WS_B1P   = WS_LB + 4096;
constexpr size_t WS_KC    = WS_SMALL + 6 * MiB;
constexpr size_t WS_VCT   = WS_KC + 512 * 1024;
constexpr size_t WS_SSQ   = WS_SMALL + 7 * MiB;
constexpr size_t WS_RTAB  = WS_SMALL + 7 * MiB + 512 * 1024 * 2;
constexpr size_t WS_LOGD  = WS_SMALL + 8 * MiB;
constexpr size_t WS_HY    = 88 * MiB;
constexpr size_t WS_ACT   = 152 * MiB;
constexpr size_t WS_CONCAT= 368 * MiB;
constexpr size_t WS_OW    = 432 * MiB;
constexpr size_t WS_U0    = 464 * MiB;
constexpr size_t WS_OC    = 480 * MiB;
constexpr size_t WS_END   = 512 * MiB;
constexpr size_t A0_GQ = 0, A0_GK = 16 * MiB, A0_GZ = 32 * MiB, A0_GVT = 64 * MiB, A0_NQ = 96 * MiB, A0_NZ = 128 * MiB;
constexpr size_t A0_NKC = 160 * MiB, A0_NVC = 169 * MiB, A0_NKS = 178 * MiB, A0_NKW = 186 * MiB, A0_NVST = 194 * MiB, A0_NVWT = 202 * MiB;
constexpr size_t A0_GLR = 210 * MiB, A0_NGATE = 211 * MiB;
constexpr size_t ACT_BYTES = 216 * MiB;
static_assert(A0_NVWT + 8 * MiB <= A0_GLR && A0_GLR + 1 * MiB <= A0_NGATE && A0_NGATE + 2 * MiB <= ACT_BYTES, "layer-0 act map");
constexpr size_t A1_HQ = 0, A1_HF = 32 * MiB, A1_HZ = 64 * MiB, A1_SZ = 96 * MiB, A1_BC = 128 * MiB, A1_HIT = 144 * MiB, A1_XST = 176 * MiB, A1_SDT = 208 * MiB, A1_BS = 209 * MiB, A1_DTV = 210 * MiB, A1_WJ = 211 * MiB;
static_assert(A1_WJ + 1 * MiB <= ACT_BYTES && A1_XST + 32 * MiB <= A1_SDT && WS_ACT + ACT_BYTES <= WS_CONCAT && WS_CONCAT + 64 * MiB <= WS_OW && WS_OW + 32 * MiB <= WS_U0 && WS_U0 + 16 * MiB <= WS_OC && WS_OC + 32 * MiB <= WS_END, "ws map");
constexpr int CW_BAR = 4096;

constexpr int RING_BYTES = 147456;
constexpr int LDSCTL_OFF = RING_BYTES, MISC_OFF = LDSCTL_OFF + 320;
constexpr int LDS_BYTES = RING_BYTES + 1024;
constexpr int NWAVES = 8, NTHR = 512;

struct Args { const float* in[27]; float* out; unsigned char* ws; int ph_lo, ph_hi; };
typedef const __attribute__((address_space(4))) Args CArgs;

struct Frame {
    LAS unsigned char* lds;
    int tid, lane, wave, G, bid;
};
DI float wave_sum(float v) {
#pragma unroll
    for (int o = 1; o < 64; o <<= 1) v += __shfl_xor(v, o);
    return v;
}

DI int dperm(int p) { return (p >> 1) + 64 * (p & 1); }
DI int src_wn0(int n) {
    if (n < 1024) return n;
    if (n < 2048) return 2064 + (n - 1024);
    if (n < 3072) { const int r = n - 2048; return 3088 + (r & ~127) + dperm(r & 127); }
    if (n < 3328) { const int r = n - 3072; return 4112 + (r & ~127) + dperm(r & 127); }
    if (n < 3584) { const int r = n - 3328; return 4624 + (r & ~127) + dperm(r & 127); }
    if (n < 3840) { const int r = n - 3584; return 5136 + (r & ~127) + dperm(r & 127); }
    if (n < 4096) return 4368 + (n - 3840);
    if (n < 5120) return 5672 + (n - 4096);
    const int r = n - 5120; if (r < 16) return 2048 + r; if (r < 40) return 5648 + (r - 16); return -1;
}
DI int src_wt0(int n) { if (n < 1024) return 1024 + n; if (n < 1280) return 4880 + (n - 1024); return 5392 + (n - 1280); }
DI int src_wn1(int n) {
    if (n < 1024) return n;
    if (n < 2048) return n;
    if (n < 3072) return 3072 + (n - 2048);
    if (n < 4096) return 4096 + (n - 3072);
    if (n < 4608) return 6144 + (n - 4096);
    const int r = n - 4608; return r < 16 ? 6656 + r : -1;
}
DI int src_wt1(int n) { return n < 1024 ? 2048 + n : 5120 + (n - 1024); }
template <int MID> DI int tr_srccol(int n) {
    if constexpr (MID == 0) return src_wn0(n); else if constexpr (MID == 1) return src_wt0(n); else if constexpr (MID == 5) return src_wn1(n); else if constexpr (MID == 6) return src_wt1(n); else return n;
}
template <int MID> DI int tr_srcrow(int k) {
    if constexpr (MID == 3) return (k & ~127) + dperm(k & 127);
    else if constexpr (MID == 7) return k < 1024 ? 1024 + k : k - 1024;
    else return k;
}
template <int MID> DI void tr_item(const float* W, int ldw, bf16_t* WT, int Kd, int Nd, const float* kscale, LAS float* scr, int item, int lane) {
    const int nblk = Nd / 32, kb = item / nblk, nb = item % nblk, k0 = 64 * kb, n0 = 32 * nb;
    const int sc = tr_srccol<MID>(n0 + (lane & 31));
#pragma unroll 8
    for (int i = 0; i < 32; ++i) { const int kk = 2 * i + (lane >> 5); const int sr = tr_srcrow<MID>(k0 + kk);
        float v = sc >= 0 ? W[(size_t)sr * ldw + sc] : 0.f;
        if constexpr (MID == 7) { if (k0 + kk < 1024) v *= kscale[k0 + kk]; }
        scr[kk * 33 + (lane & 31)] = v; }
    asm volatile("s_waitcnt lgkmcnt(0)" ::: "memory");
    const int c = lane & 7;
#pragma unroll
    for (int j = 0; j < 4; ++j) { const int n = (lane >> 3) + 8 * j; const LAS float* s = scr + (8 * c) * 33 + n;
        u32x4 o; o.x = pk2(s[0 * 33], s[1 * 33]); o.y = pk2(s[2 * 33], s[3 * 33]); o.z = pk2(s[4 * 33], s[5 * 33]); o.w = pk2(s[6 * 33], s[7 * 33]);
        *(u32x4*)(WT + (size_t)(n0 + n) * Kd + k0 + 8 * c) = o; }
    asm volatile("s_waitcnt lgkmcnt(0)" ::: "memory");
}
DI void p0_prologue(const Frame& F, CArgs& a) {
    unsigned char* ws = a.ws;
    LAS float* scr = (LAS float*)(F.lds + F.wave * 16384);
    const int gw = F.bid * NWAVES + F.wave, NGW = F.G * NWAVES;
    constexpr int I0 = 32 * (NN0 / 32), I1 = 32 * (NT0 / 32), I2 = 32 * 64, I3 = 64 * 8, I4 = 64 * 8, I5 = 32 * (NN1 / 32), I6 = 32 * (NT1 / 32), I7 = 32 * 64;
    constexpr int NITEMS = I0 + I1 + I2 + I3 + I4 + I5 + I6 + I7;
    for (int it = gw; it < NITEMS; it += NGW) {
        int r = it;
        if (r < I0) { tr_item<0>(a.in[6], N_EVEN, (bf16_t*)(ws + WS_WN0), DM, NN0, nullptr, scr, r, F.lane); continue; } r -= I0;
        if (r < I1) { tr_item<1>(a.in[6], N_EVEN, (bf16_t*)(ws + WS_WT0), DM, NT0, nullptr, scr, r, F.lane); continue; } r -= I1;
        if (r < I2) { tr_item<2>(a.in[7], DM, (bf16_t*)(ws + WS_WO0), DM, DM, nullptr, scr, r, F.lane); continue; } r -= I2;
        if (r < I3) { tr_item<3>(a.in[12], 256, (bf16_t*)(ws + WS_W1K), 4096, 256, nullptr, scr, r, F.lane); continue; } r -= I3;
        if (r < I4) { tr_item<4>(a.in[15], 256, (bf16_t*)(ws + WS_W1V), 4096, 256, nullptr, scr, r, F.lane); continue; } r -= I4;
        if (r < I5) { tr_item<5>(a.in[17], N_ODD, (bf16_t*)(ws + WS_WN1), DM, NN1, nullptr, scr, r, F.lane); continue; } r -= I5;
        if (r < I6) { tr_item<6>(a.in[17], N_ODD, (bf16_t*)(ws + WS_WT1), DM, NT1, nullptr, scr, r, F.lane); continue; } r -= I6;
        tr_item<7>(a.in[18], DM, (bf16_t*)(ws + WS_WO1), DM, DM, a.in[26], scr, r, F.lane);
    }
    __syncthreads();
    {
        LAS float* cact = (LAS float*)(F.lds);
        LAS float* red = (LAS float*)(F.lds + 16384);
        for (int e = F.tid; e < 2 * DM; e += NTHR) cact[e] = siluf_(a.in[1][e]);
        __syncthreads();
        for (int it = F.bid; it < 2 * 96; it += F.G) {
            const int l = it / 96, n0 = (it % 96) * 64, n = n0 + F.lane;
            const float* W = a.in[2] + (size_t)l * DM * 6144;
            float a0 = 0.f, a1 = 0.f;
            const int kb = F.wave * 256;
#pragma unroll 8
            for (int k = kb; k < kb + 256; ++k) { const float w = W[(size_t)k * 6144 + n]; a0 += cact[k] * w; a1 += cact[DM + k] * w; }
            red[(F.wave * 2 + 0) * 64 + F.lane] = a0; red[(F.wave * 2 + 1) * 64 + F.lane] = a1;
            __syncthreads();
            if (F.tid < 128) { const int b = F.tid >> 6, ln = F.tid & 63; float s = 0.f;
#pragma unroll
                for (int w = 0; w < 8; ++w) s += red[(w * 2 + b) * 64 + ln];
                ((float*)(ws + WS_MOD))[(size_t)(l * 2 + b) * 6144 + n0 + ln] = s + a.in[3][l * 6144 + n0 + ln]; }
            __syncthreads();
        }
    }
    {
        const int gt = F.bid * NTHR + F.tid, NGT = F.G * NTHR;
        for (int e = gt; e < SEQ * 64; e += NGT) {
            const int pos = e >> 6, i = e & 63;
            double fr = 1.0; const double r1 = 0.86596432336006535;
            for (int q = 0; q < i; ++q) fr *= r1;
            const float invf32 = (float)fr;
            const float angf = (float)pos * invf32;
            double x = (double)angf;
            const double TWO_PI = 6.283185307179586476925, INV_2PI = 0.15915494309189533577;
            double kq = __builtin_rint(x * INV_2PI); x -= kq * TWO_PI;
            const double HALF_PI = 1.5707963267948966192;
            double qd = __builtin_rint(x / HALF_PI); const double r = x - qd * HALF_PI; const int qi = ((int)qd) & 3;
            const double r2 = r * r;
            const double s = r * (1.0 + r2 * (-1.0 / 6 + r2 * (1.0 / 120 + r2 * (-1.0 / 5040 + r2 * (1.0 / 362880 + r2 * (-1.0 / 39916800 + r2 * (1.0 / 6227020800.0)))))));
            const double cc = 1.0 + r2 * (-0.5 + r2 * (1.0 / 24 + r2 * (-1.0 / 720 + r2 * (1.0 / 40320 + r2 * (-1.0 / 3628800 + r2 * (1.0 / 479001600.0 + r2 * (-1.0 / 87178291200.0)))))));
            double sn, cs;
            if (qi == 0) { sn = s; cs = cc; } else if (qi == 1) { sn = cc; cs = -s; } else if (qi == 2) { sn = -s; cs = -cc; } else { sn = -cc; cs = s; }
            ((f32x2*)(ws + WS_ROPE))[e] = (f32x2){(float)cs, (float)sn};
        }
    }
    if (F.bid == 0) { for (int d = F.tid; d < 1024; d += NTHR) { const float g0 = a.in[19][d], g1 = a.in[19][1024 + d]; ((float*)(ws + WS_LB))[d] = 1.f / (1.f + __expf(g0 - g1)); } }
    if (F.bid >= 1 && F.bid <= 128) {
        const int m = (F.bid - 1) >> 6, j = (F.bid - 1) & 63;
        const float* pe = a.in[m ? 14 : 11]; const float* w1 = a.in[m ? 15 : 12];
        LAS float* red = (LAS float*)(F.lds);
        const int cidx = F.tid & 255, kh = F.tid >> 8; float s0 = 0.f, s1 = 0.f;
        const int kb = 64 * j + 32 * kh;
#pragma unroll
        for (int k = 0; k < 32; k += 2) { s0 += pe[kb + k] * w1[(size_t)(kb + k) * 256 + cidx]; s1 += pe[kb + k + 1] * w1[(size_t)(kb + k + 1) * 256 + cidx]; }
        __syncthreads(); red[F.tid] = s0 + s1; __syncthreads();
        if (F.tid < 256) ((float*)(ws + WS_B1P))[(size_t)(m * 64 + j) * 256 + F.tid] = red[F.tid] + red[256 + F.tid];
        __syncthreads();
    }
}

DI void load_row_f32(const float* row, int lane, f32x4 (&v)[8]) {
#pragma unroll
    for (int j = 0; j < 8; ++j) v[j] = *(const f32x4*)(row + 4 * lane + 256 * j);
}
DI float sumsq8(const f32x4 (&v)[8]) { float s = 0.f;
#pragma unroll
    for (int j = 0; j < 8; ++j) s += (v[j].x * v[j].x + v[j].y * v[j].y) + (v[j].z * v[j].z + v[j].w * v[j].w);
    return wave_sum(s); }
DI void modulate_store(const f32x4 (&v)[8], float rs, const float* w, const float* mod  , bf16_t* hrow, int lane) {
#pragma unroll
    for (int j = 0; j < 8; ++j) { const int c = 4 * lane + 256 * j;
        const f32x4 ww = *(const f32x4*)(w + c), sh = *(const f32x4*)(mod + c), sc = *(const f32x4*)(mod + 2048 + c);
        const f32x4 o = v[j] * rs * ww * (sc + 1.0f) + sh;
        u32x2 p; p.x = pk2(o.x, o.y); p.y = pk2(o.z, o.w); *(u32x2*)(hrow + c) = p; }
}
DI void p1_prenorm0(const Frame& F, CArgs& a) {
    const int gw = F.bid * NWAVES + F.wave, NGW = F.G * NWAVES;
    bf16_t* H = (bf16_t*)(a.ws + WS_HY);
    for (int m = gw; m < MTOK; m += NGW) {
        f32x4 v[8]; load_row_f32(a.in[0] + (size_t)m * DM, F.lane, v);
        const float rs = 1.0f / sqrtf(sumsq8(v) * (1.0f / DM) + EPS);
        modulate_store(v, rs, a.in[4], (const float*)(a.ws + WS_MOD) + (size_t)(0 * 2 + (m >> 13)) * 6144, H + (size_t)m * DM, F.lane);
    }
}
template <int LAYER> DI void p_residual(const Frame& F, CArgs& a) {
    const int gw = F.bid * NWAVES + F.wave, NGW = F.G * NWAVES;
    bf16_t* HY = (bf16_t*)(a.ws + WS_HY);
    const float* xin = LAYER == 0 ? a.in[0] : a.out;
    for (int m = gw; m < MTOK; m += NGW) {
        f32x4 y[8];
#pragma unroll
        for (int j = 0; j < 8; ++j) { const u32x2 p = *(const u32x2*)(HY + (size_t)m * DM + 4 * F.lane + 256 * j); y[j] = (f32x4){bflo(p.x), bfhi(p.x), bflo(p.y), bfhi(p.y)}; }
        const float rsy = 1.0f / sqrtf(sumsq8(y) * (1.0f / DM) + EPS);
        const float* mod = (const float*)(a.ws + WS_MOD) + (size_t)(LAYER * 2 + (m >> 13)) * 6144;
        f32x4 x[8]; load_row_f32(xin + (size_t)m * DM, F.lane, x);
#pragma unroll
        for (int j = 0; j < 8; ++j) { const int c = 4 * F.lane + 256 * j;
            const f32x4 pw = *(const f32x4*)(a.in[5] + LAYER * DM + c), gt = *(const f32x4*)(mod + 4096 + c);
            x[j] = x[j] + gt * (y[j] * rsy * pw);
            *(f32x4*)(a.out + (size_t)m * DM + c) = x[j]; }
        if constexpr (LAYER == 0) {
            const float rs = 1.0f / sqrtf(sumsq8(x) * (1.0f / DM) + EPS);
            modulate_store(x, rs, a.in[4] + DM, (const float*)(a.ws + WS_MOD) + (size_t)(1 * 2 + (m >> 13)) * 6144, HY + (size_t)m * DM, F.lane);
        }
    }
}
constexpr float QSCALE_GLA = 0.08838834764831845f;
constexpr float QSCALE_NSA = 0.12751743082459868f;
template <int LAYER> struct EpiProj {
    static constexpr bool PERM = true;
    unsigned char* ws;
    DI bool operator()(f32x4 (&acc)[2][2][4][2], const pg8::Unit& u, int wr, int wc, int fr, int fq) const {
        unsigned char* act = ws + WS_ACT;
        int mode = 0, ldc = 1024, coff = 0; size_t boff = 0; float sc = 1.f;
        const int pn = u.pn, pm = u.pm;
        if constexpr (LAYER == 0) {
            if (u.job == 0) {
                if (pn < 2)       { boff = A0_GQ; ldc = 512; coff = pn * 256; sc = QSCALE_GLA; }
                else if (pn < 4)  { boff = A0_GK; ldc = 512; coff = (pn - 2) * 256; }
                else if (pn < 8)  { boff = A0_GZ; coff = (pn - 4) * 256; }
                else if (pn < 12) { boff = A0_NQ; coff = (pn - 8) * 256; mode = 1; sc = QSCALE_NSA; }
                else if (pn == 12) { boff = A0_NKC; mode = 2; }
                else if (pn == 13) { boff = A0_NKS; mode = 2; }
                else if (pn == 14) { boff = A0_NKW; mode = 2; }
                else if (pn == 15) { boff = A0_NVC; mode = 3; }
                else if (pn < 20) { boff = A0_NZ; coff = (pn - 16) * 256; }
                else mode = 4;
            } else {
                if (pm < 4) { boff = A0_GVT; ldc = MTOK; coff = pn * 256; }
                else { boff = pm == 4 ? A0_NVST : A0_NVWT; mode = 6; }
            }
        } else {
            if (u.job == 0) {
                if (pn < 4)       { boff = A1_HQ; coff = pn * 256; }
                else if (pn < 8)  { boff = A1_HF; coff = (pn - 4) * 256; }
                else if (pn < 12) { boff = A1_HZ; coff = (pn - 8) * 256; }
                else if (pn < 16) { boff = A1_SZ; coff = (pn - 12) * 256; }
                else if (pn < 18) { boff = A1_BC; ldc = 512; coff = (pn - 16) * 256; }
                else mode = 4;
            } else {
                if (pm < 4) { boff = A1_HIT; ldc = MTOK; coff = pn * 256; }
                else { boff = A1_XST - (size_t)1024 * MTOK * 2; ldc = MTOK; coff = pn * 256; }
            }
        }
        bf16_t* base = (bf16_t*)(act + boff);
        const f32x2* rope = (const f32x2*)(ws + WS_ROPE);
#pragma unroll
        for (int ai = 0; ai < 2; ++ai)
#pragma unroll
            for (int m = 0; m < 4; ++m) {
                const int row = pm * 256 + ai * 128 + wr * 64 + m * 16 + fr;
#pragma unroll
                for (int bj = 0; bj < 2; ++bj) {
                    const int c8 = bj * 128 + wc * 32 + 8 * fq;
                    f32x4 v0 = acc[ai][bj][m][0], v1 = acc[ai][bj][m][1];
                    if (mode == 4) {
                        if constexpr (LAYER == 0) {
                            if (c8 < 16) { float* d = (float*)(act + A0_GLR) + (size_t)row * 16 + c8; *(f32x4*)d = v0; *(f32x4*)(d + 4) = v1; }
                            else if (c8 < 40) { float* d = (float*)(act + A0_NGATE) + (size_t)row * 24 + (c8 - 16);
                                f32x4 g0, g1;
#pragma unroll
                                for (int e = 0; e < 4; ++e) { g0[e] = sigmoidf_(v0[e]); g1[e] = sigmoidf_(v1[e]); }
                                *(f32x4*)d = g0; *(f32x4*)(d + 4) = g1; }
                        } else {
                            if (c8 < 16) { float* d = (float*)(act + A1_SDT) + (size_t)row * 16 + c8; *(f32x4*)d = v0; *(f32x4*)(d + 4) = v1; }
                        }
                        continue;
                    }
                    if (mode == 1 || mode == 2) {
                        const int i0 = (c8 & 127) >> 1;
                        const f32x4* cs = (const f32x4*)(rope + (size_t)(row & (SEQ - 1)) * 64 + i0);
                        const f32x4 c01 = cs[0], c23 = cs[1];
                        f32x4 r0, r1;
                        r0[0] = v0[0] * c01[0] - v0[1] * c01[1]; r0[1] = v0[0] * c01[1] + v0[1] * c01[0];
                        r0[2] = v0[2] * c01[2] - v0[3] * c01[3]; r0[3] = v0[2] * c01[3] + v0[3] * c01[2];
                        r1[0] = v1[0] * c23[0] - v1[1] * c23[1]; r1[1] = v1[0] * c23[1] + v1[1] * c23[0];
                        r1[2] = v1[2] * c23[2] - v1[3] * c23[3]; r1[3] = v1[2] * c23[3] + v1[3] * c23[2];
                        v0 = r0; v1 = r1;
                    }
                    v0 = v0 * sc; v1 = v1 * sc;
                    u32x4 w; w.x = pk2(v0[0], v0[1]); w.y = pk2(v0[2], v0[3]); w.z = pk2(v1[0], v1[1]); w.w = pk2(v1[2], v1[3]);
                    bf16_t* dst;
                    if (mode == 2 || mode == 3) dst = base + ((size_t)(((row >> 13) * 2 + (c8 >> 7)) * SEQ + (row & (SEQ - 1)))) * 128 + (c8 & 127);
                    else if (mode == 6) { const int fl = row & 255, tok = pn * 256 + c8; dst = base + ((size_t)(((tok >> 13) * 2 + (fl >> 7)) * 128 + (fl & 127))) * SEQ + (tok & (SEQ - 1)); }
                    else dst = base + (size_t)row * ldc + coff + c8;
                    *(u32x4*)dst = w;
                }
            }
        return false;
    }
};
struct EpiBf16 {
    static constexpr bool PERM = true;
    bf16_t* O; int ldc;
    DI bool operator()(f32x4 (&acc)[2][2][4][2], const pg8::Unit& u, int wr, int wc, int fr, int fq) const {
#pragma unroll
        for (int ai = 0; ai < 2; ++ai)
#pragma unroll
            for (int m = 0; m < 4; ++m) { bf16_t* rowp = O + (size_t)(u.pm * 256 + ai * 128 + wr * 64 + m * 16 + fr) * ldc + u.pn * 256 + wc * 32 + 8 * fq;
#pragma unroll
                for (int bj = 0; bj < 2; ++bj) { const f32x4 v0 = acc[ai][bj][m][0], v1 = acc[ai][bj][m][1];
                    u32x4 w; w.x = pk2(v0[0], v0[1]); w.y = pk2(v0[2], v0[3]); w.z = pk2(v1[0], v1[1]); w.w = pk2(v1[2], v1[3]);
                    *(u32x4*)(rowp + bj * 128) = w; } }
        return false;
    }
};
struct EpiBf16Mid {
    static constexpr bool PERM = true;
    bf16_t* O; int ldc; const float* rtab;
    DI bool operator()(f32x4 (&acc)[2][2][4][2], const pg8::Unit& u, int wr, int wc, int fr, int fq) const {
        if (u.ks == 0) {
#pragma unroll
            for (int ai = 0; ai < 2; ++ai)
#pragma unroll
                for (int m = 0; m < 4; ++m) { const float r = rtab[u.pm * 256 + ai * 128 + wr * 64 + m * 16 + fr];
#pragma unroll
                    for (int bj = 0; bj < 2; ++bj) { acc[ai][bj][m][0] = acc[ai][bj][m][0] * r; acc[ai][bj][m][1] = acc[ai][bj][m][1] * r; } }
            return true;
        }
        EpiBf16 e{O, ldc}; return e(acc, u, wr, wc, fr, fq);
    }
};
struct EpiF32Part {
    static constexpr bool PERM = true;
    float* P;
    DI bool operator()(f32x4 (&acc)[2][2][4][2], const pg8::Unit& u, int wr, int wc, int fr, int fq) const {
        float* base = P + (size_t)(u.job * 8 + u.ks) * 2048 * 256;
#pragma unroll
        for (int ai = 0; ai < 2; ++ai)
#pragma unroll
            for (int m = 0; m < 4; ++m) { float* rowp = base + (size_t)(u.pm * 256 + ai * 128 + wr * 64 + m * 16 + fr) * 256 + wc * 32 + 8 * fq;
#pragma unroll
                for (int bj = 0; bj < 2; ++bj) { *(f32x4*)(rowp + bj * 128) = acc[ai][bj][m][0]; *(f32x4*)(rowp + bj * 128 + 4) = acc[ai][bj][m][1]; } }
        return false;
    }
};
template <int MODE> struct LACfg;
template <> struct LACfg<0> { static constexpr int CL = 64, NH = 1, HA = 1, NCH = 8; };
template <> struct LACfg<1> { static constexpr int CL = 32, NH = 2, HA = 2, NCH = 16; };
template <> struct LACfg<2> { static constexpr int CL = 64, NH = 1, HA = 4, NCH = 8; };
constexpr int LA_NSC = 16, LA_ITEMS = 128;
DI float log_sigmoid_(float x) { return fminf(x, 0.f) - __logf(1.0f + __expf(-fabsf(x))); }
DI float softplus_(float x) { return fmaxf(x, 0.f) + __logf(1.0f + __expf(-fabsf(x))); }

template <int MODE> DI void la_prep(const Frame& F, CArgs& a, int item) {
    typedef LACfg<MODE> C;
    constexpr int CL = C::CL, NH = C::NH, PQ = 272;
    constexpr int O_Q = 0, O_K = O_Q + NH * CL * PQ, O_RAW = O_K + NH * CL * PQ, O_GS = O_RAW + 4096;
    LAS unsigned char* L = F.lds; unsigned char* ws = a.ws; unsigned char* act = ws + WS_ACT;
    const int tid = F.tid;
    const int c = item % (SEQ / CL), bh = item / (SEQ / CL), b = bh >> 2, hx = bh & 3;
    const size_t tok0 = (size_t)b * SEQ + (size_t)c * CL;
    bf16_t* kg; bf16_t* qg; int ldk;
    if constexpr (MODE == 0) { kg = (bf16_t*)(act + A0_GK) + tok0 * 512 + hx * 128; qg = (bf16_t*)(act + A0_GQ) + tok0 * 512 + hx * 128; ldk = 512; }
    else { kg = (bf16_t*)(act + A1_HF) + tok0 * 1024 + hx * 256; qg = (bf16_t*)(act + A1_HQ) + tok0 * 1024 + hx * 256; ldk = 1024; }
    __syncthreads();
    { u32x4 kq[4];
#pragma unroll
        for (int i = 0; i < 2; ++i) { const int ci = tid + 512 * i, hh2 = (NH == 2) ? (ci >> 9) : 0, j = (ci >> 4) & (CL - 1), cc = ci & 15;
            kq[i] = *(const u32x4*)(kg + (size_t)j * ldk + hh2 * 128 + cc * 8); kq[2 + i] = *(const u32x4*)(qg + (size_t)j * ldk + hh2 * 128 + cc * 8); }
        f32x4 gr = {0.f, 0.f, 0.f, 0.f};
        if constexpr (MODE == 0) { if (tid < 256) gr = *(const f32x4*)((const float*)(act + A0_GLR) + tok0 * 16 + tid * 4); }
#pragma unroll
        for (int i = 0; i < 2; ++i) { const int ci = tid + 512 * i, hh2 = (NH == 2) ? (ci >> 9) : 0, j = (ci >> 4) & (CL - 1), cc = ci & 15;
            *(LAS u32x4*)(L + O_K + (hh2 * CL + j) * PQ + cc * 16) = kq[i]; *(LAS u32x4*)(L + O_Q + (hh2 * CL + j) * PQ + cc * 16) = kq[2 + i]; }
        if constexpr (MODE == 0) { if (tid < 256) *(LAS f32x4*)(L + O_RAW + tid * 16) = gr; } }
    if constexpr (MODE == 0) {
        const int d = tid & 127, jg = tid >> 7;
        float wu[16];
#pragma unroll
        for (int r = 0; r < 16; ++r) wu[r] = a.in[8][r * 512 + hx * 128 + d];
        const float bu = a.in[9][hx * 128 + d];
        __syncthreads();
        float lg[16]; float run = 0.f;
#pragma unroll
        for (int jj = 0; jj < 16; ++jj) { const LAS f32x4* gl = (const LAS f32x4*)(L + O_RAW + (jg * 16 + jj) * 64);
            const f32x4 g0 = gl[0], g1 = gl[1], g2 = gl[2], g3 = gl[3];
            float x = bu;
#pragma unroll
            for (int e = 0; e < 4; ++e) { x += g0[e] * wu[e]; x += g1[e] * wu[4 + e]; x += g2[e] * wu[8 + e]; x += g3[e] * wu[12 + e]; }
            run += log_sigmoid_(x) * (1.0f / 16.0f); lg[jj] = run; }
        ((LAS float*)(L + O_GS))[jg * 128 + d] = run;
        __syncthreads();
        float pre = 0.f, tot = 0.f;
#pragma unroll
        for (int g = 0; g < 4; ++g) { const float v = ((LAS float*)(L + O_GS))[g * 128 + d]; if (g < jg) pre += v; tot += v; }
        if (jg == 0) ((float*)(ws + WS_BL))[(size_t)item * 128 + d] = tot;
#pragma unroll
        for (int jj = 0; jj < 16; ++jj) { const int j = jg * 16 + jj; const float bb = pre + lg[jj];
            LAS unsigned short* kp = (LAS unsigned short*)(L + O_K + j * PQ + d * 2); LAS unsigned short* qp = (LAS unsigned short*)(L + O_Q + j * PQ + d * 2);
            const unsigned pk = pk2(bf2f(*kp) * __expf(-bb), bf2f(*qp) * __expf(bb)); *kp = (unsigned short)(pk & 0xffffu); *qp = (unsigned short)(pk >> 16); }
    } else {
        const int d = tid & 127, hh = (tid >> 7) & 1, jg = tid >> 8;
        const float lbv = ((const float*)(ws + WS_LB))[(2 * hx + hh) * 128 + d];
        __syncthreads();
        float lg[16], kk[16]; float run = 0.f;
#pragma unroll
        for (int jj = 0; jj < 16; ++jj) { const float z = bf2f(*(const LAS unsigned short*)(L + O_K + (hh * CL + jg * 16 + jj) * PQ + d * 2));
            const float sg = __builtin_amdgcn_rcpf(1.0f + __expf(-z));
            run += __logf(lbv + (1.f - lbv) * sg); lg[jj] = run; kk[jj] = (1.f - lbv) * (1.f - sg); }
        ((LAS float*)(L + O_GS))[jg * 256 + hh * 128 + d] = run;
        __syncthreads();
        const float g0 = ((LAS float*)(L + O_GS))[hh * 128 + d], g1 = ((LAS float*)(L + O_GS))[256 + hh * 128 + d];
        if (jg == 0) ((float*)(ws + WS_BL))[(size_t)item * 256 + hh * 128 + d] = g0 + g1;
        const float pre = jg ? g0 : 0.f;
#pragma unroll
        for (int jj = 0; jj < 16; ++jj) { const int j = jg * 16 + jj; const float bb = pre + lg[jj];
            LAS unsigned short* kp = (LAS unsigned short*)(L + O_K + (hh * CL + j) * PQ + d * 2); LAS unsigned short* qp = (LAS unsigned short*)(L + O_Q + (hh * CL + j) * PQ + d * 2);
            const unsigned pk = pk2(kk[jj] * __expf(-bb), bf2f(*qp) * __expf(bb)); *kp = (unsigned short)(pk & 0xffffu); *qp = (unsigned short)(pk >> 16); }
    }
    __syncthreads();
#pragma unroll
    for (int i = 0; i < 2; ++i) { const int ci = tid + 512 * i, hh2 = (NH == 2) ? (ci >> 9) : 0, j = (ci >> 4) & (CL - 1), cc = ci & 15;
        *(u32x4*)(kg + (size_t)j * ldk + hh2 * 128 + cc * 8) = *(const LAS u32x4*)(L + O_K + (hh2 * CL + j) * PQ + cc * 16);
        *(u32x4*)(qg + (size_t)j * ldk + hh2 * 128 + cc * 8) = *(const LAS u32x4*)(L + O_Q + (hh2 * CL + j) * PQ + cc * 16); }
}
DI float silu_fast(float x) { return x * __builtin_amdgcn_rcpf(1.0f + __expf(-x)); }
DI void ssd_prep(const Frame& F, CArgs& a) {
    unsigned char* ws = a.ws; unsigned char* act = ws + WS_ACT;
    const int gt = F.bid * NTHR + F.tid, NGT = F.G * NTHR;
    for (int it = gt; it < 1024 * 512; it += NGT) { const int ch = it >> 9, run = it & 511; const size_t t0 = (size_t)run * 32;
        const bf16_t* rp = (const bf16_t*)(act + A1_XST) + (size_t)ch * MTOK + t0; bf16_t* op = (bf16_t*)(ws + WS_OC) + (size_t)ch * MTOK + t0;
        const float w0 = a.in[21][ch], w1 = a.in[21][1536 + ch], w2 = a.in[21][2 * 1536 + ch], w3 = a.in[21][3 * 1536 + ch], cb = a.in[22][ch];
        u32x4 p[4];
#pragma unroll
        for (int q = 0; q < 4; ++q) p[q] = *(const u32x4*)(rp + 8 * q);
        float x0 = 0.f, x1 = 0.f, x2 = 0.f;
        if ((t0 & (SEQ - 1)) != 0) { const u32x2 h2 = *(const u32x2*)(rp - 4); x0 = bfhi(h2.x); x1 = bflo(h2.y); x2 = bfhi(h2.y); }
#pragma unroll
        for (int q = 0; q < 4; ++q) { unsigned o[4];
#pragma unroll
            for (int e = 0; e < 4; ++e) { const float xa = bflo(p[q][e]), xb = bfhi(p[q][e]);
                const float ya = silu_fast(cb + w0 * x0 + w1 * x1 + w2 * x2 + w3 * xa), yb = silu_fast(cb + w0 * x1 + w1 * x2 + w2 * xa + w3 * xb);
                x0 = x2; x1 = xa; x2 = xb; o[e] = pk2(ya, yb); }
            *(u32x4*)(op + 8 * q) = (u32x4){o[0], o[1], o[2], o[3]}; } }
    for (int it = gt; it < 2048 * 64; it += NGT) { const int run = it >> 6, cg = it & 63; const size_t t0 = (size_t)run * 8;
        const bf16_t* rp = (const bf16_t*)(act + A1_BC) + t0 * 512 + cg * 8; bf16_t* op = (bf16_t*)(ws + WS_U0) + t0 * 512 + cg * 8;
        const int ch = 1024 + cg * 8;
        u32x4 r[11];
        const int tpos = (int)(t0 & (SEQ - 1));
#pragma unroll
        for (int k = 0; k < 11; ++k) { r[k] = (u32x4){0u, 0u, 0u, 0u}; if (tpos + k - 3 >= 0) r[k] = *(const u32x4*)(rp + (long)(k - 3) * 512); }
        f32x4 wa[4], wb[4]; const f32x4 ba = *(const f32x4*)(a.in[22] + ch), bb = *(const f32x4*)(a.in[22] + ch + 4);
#pragma unroll
        for (int k = 0; k < 4; ++k) { wa[k] = *(const f32x4*)(a.in[21] + k * 1536 + ch); wb[k] = *(const f32x4*)(a.in[21] + k * 1536 + ch + 4); }
#pragma unroll
        for (int t = 0; t < 8; ++t) { float y[8];
#pragma unroll
            for (int e = 0; e < 4; ++e) { float s0 = ba[e], s1 = bb[e];
#pragma unroll
                for (int k = 0; k < 4; ++k) { const u32x4 x = r[t + k]; const float xa = (e & 1) ? bfhi(x[e >> 1]) : bflo(x[e >> 1]); const float xb = (e & 1) ? bfhi(x[2 + (e >> 1)]) : bflo(x[2 + (e >> 1)]);
                    s0 += wa[k][e] * xa; s1 += wb[k][e] * xb; }
                y[e] = silu_fast(s0); y[4 + e] = silu_fast(s1); }
            *(u32x4*)(op + (size_t)t * 512) = (u32x4){pk2(y[0], y[1]), pk2(y[2], y[3]), pk2(y[4], y[5]), pk2(y[6], y[7])}; } }
    { const int gw = F.bid * NWAVES + F.wave, NGW = F.G * NWAVES, j = F.lane;
        for (int it = gw; it < 256 * 16; it += NGW) { const int head = it & 15, ck = it >> 4; const size_t gi = ((size_t)ck * 64 + j) * 16 + head;
            const float dtv = softplus_(((const float*)(act + A1_SDT))[gi] + a.in[23][head]);
            float bs = dtv * (-__expf(a.in[24][head]));
#pragma unroll
            for (int o = 1; o < 64; o <<= 1) { const float t = __shfl_up(bs, o); if (j >= o) bs += t; }
            const float bl = __shfl(bs, 63);
            ((float*)(act + A1_BS))[gi] = bs; ((float*)(act + A1_DTV))[gi] = dtv; ((float*)(act + A1_WJ))[gi] = __expf(bl - bs) * dtv; } }
}
template <int MODE, int PHASE> DI void la_phase(const Frame& F, CArgs& a, int item_first, int item_stride) {
    typedef LACfg<MODE> C;
    constexpr int CL = C::CL, NH = C::NH, HA = C::HA, NI = CL / 32, PQ = 272  , PJ = (CL + 8) * 2  ;
    constexpr int O_QH = 0, O_KH = O_QH + NH * CL * PQ, O_KT = O_KH + NH * CL * PQ, O_VT = O_KT + NH * 128 * PJ, O_ATT = O_VT + 256 * PJ, O_DEC = O_ATT + HA * CL * PJ,
                  O_GS = O_DEC + 1024, O_RED = O_GS + 4096, O_BS = O_RED + 2048, O_DT = O_BS + 1024, O_WJ = O_DT + 1024, O_LS = O_WJ + 1024, O_ENDL = O_LS + 1024;
    static_assert(O_ENDL <= RING_BYTES, "LA LDS");
    LAS unsigned char* L = F.lds;
    unsigned char* ws = a.ws; unsigned char* act = ws + WS_ACT;
    const int tid0 = F.tid, w = F.wave;
#define LAUNDER() int tid = tid0; asm volatile("" : "+v"(tid)); const int lane = tid & 63, r32 = lane & 31, h = lane >> 5; (void)lane; (void)r32; (void)h
    float* Ubase = (float*)(ws + (MODE == 0 ? WS_U0 : (MODE == 1 ? WS_OW : WS_OW + 16 * MiB)));
    float* LOGD = (float*)(ws + WS_LOGD) + (size_t)MODE * LA_ITEMS * 256;
    const int hk = (MODE == 1) ? (w >> 2) : 0;
    const int hs = (MODE == 2) ? (w >> 1) : 0;
#pragma unroll 1
    for (int item = item_first; item < LA_ITEMS; item += item_stride) {
        const int sc = item & 15, bh = item >> 4, b = bh >> 2, hx = bh & 3;
        f32x16 S[4];
#pragma unroll
        for (int dt = 0; dt < 4; ++dt)
#pragma unroll
            for (int r = 0; r < 16; ++r) S[dt][r] = 0.f;
        if constexpr (PHASE == 1) { LAUNDER();
            LAS float* FD = (LAS float*)L;
            __syncthreads();
            for (int e2 = tid; e2 < sc * 256; e2 += NTHR) FD[e2] = __expf(LOGD[(size_t)(bh << 4) * 256 + e2]);
            __syncthreads();
#pragma unroll 2
            for (int sp = 0; sp < sc; ++sp) {
                const float* U = Ubase + (size_t)((bh << 4) + sp) * 32768 + (size_t)w * 4096 + lane;
                float u[64];
#pragma unroll
                for (int k = 0; k < 64; ++k) u[k] = U[k * 64];
#pragma unroll
                for (int dt = 0; dt < 4; ++dt)
#pragma unroll
                    for (int q = 0; q < 4; ++q) {
                        f32x4 f;
                        if constexpr (MODE == 2) { const float fs = FD[sp * 256 + hs]; f = (f32x4){fs, fs, fs, fs}; } else f = *(const LAS f32x4*)(FD + sp * 256 + hk * 128 + 32 * dt + crow(4 * q, h));
#pragma unroll
                        for (int e2 = 0; e2 < 4; ++e2) S[dt][4 * q + e2] = S[dt][4 * q + e2] * f[e2] + u[dt * 16 + 4 * q + e2];
                    }
            }
            __syncthreads();
        }
        { LAUNDER();
        if (tid < 256) ((LAS float*)(L + O_LS))[tid] = 0.f; }
        __syncthreads();
        constexpr int CPR = CL / 8, NVQ = 256 * CPR / NTHR;
        u32x4 kr[2], qr[2], vr[NVQ]; float sg0 = 0.f, sg1 = 0.f, sg2 = 0.f;
#define STG_LOAD(cc_) do { const int c_ = (cc_); const size_t tk = (size_t)b * SEQ + sc * 512 + c_ * CL; const int citem = (b * 4 + hx) * (SEQ / CL) + sc * C::NCH + c_; \
            const bf16_t* ksrc; const bf16_t* qsrc; int ldk; \
            if constexpr (MODE == 0) { ksrc = (const bf16_t*)(act + A0_GK) + tk * 512 + hx * 128; qsrc = (const bf16_t*)(act + A0_GQ) + tk * 512 + hx * 128; ldk = 512; } \
            else if constexpr (MODE == 1) { ksrc = (const bf16_t*)(act + A1_HF) + tk * 1024 + hx * 256; qsrc = (const bf16_t*)(act + A1_HQ) + tk * 1024 + hx * 256; ldk = 1024; } \
            else { ksrc = (const bf16_t*)(ws + WS_U0) + tk * 512 + (hx >> 1) * 128; qsrc = ksrc + 256; ldk = 512; } \
            const bf16_t* vsrc = (MODE == 0) ? (const bf16_t*)(act + A0_GVT) + (size_t)(hx * 256) * MTOK + tk : (MODE == 1) ? (const bf16_t*)(act + A1_HIT) + (size_t)(hx * 256) * MTOK + tk \
                                                                                                              : (const bf16_t*)(ws + WS_OC) + (size_t)(hx * 256) * MTOK + tk; \
            _Pragma("unroll") for (int i = 0; i < 2; ++i) { const int ci = tid + 512 * i, hh2 = (NH == 2) ? (ci >> 9) : 0, j = (ci >> 4) & (CL - 1), cc = ci & 15; \
                kr[i] = *(const u32x4*)(ksrc + (size_t)j * ldk + hh2 * 128 + cc * 8); if constexpr (PHASE == 1) qr[i] = *(const u32x4*)(qsrc + (size_t)j * ldk + hh2 * 128 + cc * 8); } \
            _Pragma("unroll") for (int q = 0; q < NVQ; ++q) { const int ci = q * NTHR + tid, v = ci / CPR, cc = ci % CPR; vr[q] = *(const u32x4*)(vsrc + (size_t)v * MTOK + cc * 8); } \
            if constexpr (MODE == 2) { if (tid < 256) { const size_t gi = (tk + (tid & 63)) * 16 + 4 * hx + (tid >> 6); sg0 = ((const float*)(act + A1_BS))[gi]; sg1 = ((const float*)(act + A1_DTV))[gi]; sg2 = ((const float*)(act + A1_WJ))[gi]; } } \
            else { if (tid < NH * 128) sg0 = ((const float*)(ws + WS_BL))[(size_t)citem * (NH * 128) + tid]; } } while (0)
#define STG_STORE() do { \
            if constexpr (MODE == 2) { if (tid < 256) { const int hh = tid >> 6, j = tid & 63; const float bl = __shfl(sg0, 63); \
                    ((LAS float*)(L + O_BS))[hh * 64 + j] = sg0; ((LAS float*)(L + O_DT))[hh * 64 + j] = sg1; ((LAS float*)(L + O_WJ))[hh * 64 + j] = sg2; \
                    if (j == 0) { ((LAS float*)(L + O_DEC))[hh] = __expf(bl); ((LAS float*)(L + O_LS))[hh] += bl; } } } \
            else { if (tid < NH * 128) { ((LAS float*)(L + O_DEC))[tid] = __expf(sg0); ((LAS float*)(L + O_LS))[tid] += sg0; } } \
            _Pragma("unroll") for (int i = 0; i < 2; ++i) { const int ci = tid + 512 * i, hh2 = (NH == 2) ? (ci >> 9) : 0, j = (ci >> 4) & (CL - 1), cc = ci & 15; \
                if constexpr (PHASE == 1) { *(LAS u32x4*)(L + O_KH + (hh2 * CL + j) * PQ + cc * 16) = kr[i]; *(LAS u32x4*)(L + O_QH + (hh2 * CL + j) * PQ + cc * 16) = qr[i]; } \
                _Pragma("unroll") for (int e = 0; e < 4; ++e) { LAS unsigned char* kt = L + O_KT + (hh2 * 128 + 8 * cc + 2 * e) * PJ + j * 2; \
                    *(LAS unsigned short*)kt = (unsigned short)(kr[i][e] & 0xffffu); *(LAS unsigned short*)(kt + PJ) = (unsigned short)(kr[i][e] >> 16); } } \
            _Pragma("unroll") for (int q = 0; q < NVQ; ++q) { const int ci = q * NTHR + tid, v = ci / CPR, cc = ci % CPR; *(LAS u32x4*)(L + O_VT + v * PJ + cc * 16) = vr[q]; } } while (0)
        { LAUNDER(); STG_LOAD(0); }
#pragma unroll 1
        for (int c = 0; c < C::NCH; ++c) {
            const int tpos = sc * 512 + c * CL;
            const size_t tok0 = (size_t)b * SEQ + tpos;
            { LAUNDER();
            STG_STORE();
            }
            __syncthreads();
            if (c + 1 < C::NCH) { LAUNDER(); STG_LOAD(c + 1); }
            f32x16 oT[NI];
            if constexpr (PHASE == 1) {
                { LAUNDER();
                if constexpr (MODE == 0 || MODE == 2) {
                    if (w < 3) { const int mj = (w == 2), ni = (w >= 1);
                        f32x16 t;
#pragma unroll
                        for (int r = 0; r < 16; ++r) t[r] = 0.f;
                        { bf16x8 fa[8], fb[8];
                            __builtin_amdgcn_sched_barrier(0);
#pragma unroll
                            for (int s = 0; s < 8; ++s) { fa[s] = *(const LAS bf16x8*)(L + O_KH + (32 * mj + r32) * PQ + (16 * s + 8 * h) * 2); fb[s] = *(const LAS bf16x8*)(L + O_QH + (32 * ni + r32) * PQ + (16 * s + 8 * h) * 2); }
                            __builtin_amdgcn_sched_barrier(0);
#pragma unroll
                            for (int s = 0; s < 8; ++s) t = MFMA32(fa[s], fb[s], t);
                            __builtin_amdgcn_sched_barrier(0); }
                        const int i = 32 * ni + r32;
#pragma unroll
                        for (int hh = 0; hh < HA; ++hh) {
                            float bsi = 0.f; if constexpr (MODE == 2) bsi = ((LAS float*)(L + O_BS))[hh * 64 + i];
#pragma unroll
                            for (int q = 0; q < 4; ++q) { float o[4];
#pragma unroll
                                for (int e = 0; e < 4; ++e) { const int j = 32 * mj + crow(4 * q + e, h); float v = t[4 * q + e];
                                    if constexpr (MODE == 2) v *= __expf(fminf(bsi - ((LAS float*)(L + O_BS))[hh * 64 + j], 0.f)) * ((LAS float*)(L + O_DT))[hh * 64 + j];
                                    o[e] = (j <= i) ? v : 0.f; }
                                *(LAS u32x2*)(L + O_ATT + (hh * CL + i) * PJ + (32 * mj + crow(4 * q, h)) * 2) = (u32x2){pk2(o[0], o[1]), pk2(o[2], o[3])}; } }
                    }
                } else {
                    if (w < 2) { f32x16 t;
#pragma unroll
                        for (int r = 0; r < 16; ++r) t[r] = 0.f;
                        { bf16x8 fa[8], fb[8];
                            __builtin_amdgcn_sched_barrier(0);
#pragma unroll
                            for (int s = 0; s < 8; ++s) { fa[s] = *(const LAS bf16x8*)(L + O_KH + (w * CL + r32) * PQ + (16 * s + 8 * h) * 2); fb[s] = *(const LAS bf16x8*)(L + O_QH + (w * CL + r32) * PQ + (16 * s + 8 * h) * 2); }
                            __builtin_amdgcn_sched_barrier(0);
#pragma unroll
                            for (int s = 0; s < 8; ++s) t = MFMA32(fa[s], fb[s], t);
                            __builtin_amdgcn_sched_barrier(0); }
#pragma unroll
                        for (int q = 0; q < 4; ++q) { float o[4];
#pragma unroll
                            for (int e = 0; e < 4; ++e) { const int j = crow(4 * q + e, h); o[e] = (j <= r32) ? t[4 * q + e] : 0.f; }
                            *(LAS u32x2*)(L + O_ATT + (w * CL + r32) * PJ + crow(4 * q, h) * 2) = (u32x2){pk2(o[0], o[1]), pk2(o[2], o[3])}; }
                    }
                }
                }
                { LAUNDER();
#pragma unroll
                for (int ni = 0; ni < NI; ++ni) {
#pragma unroll
                    for (int r = 0; r < 16; ++r) oT[ni][r] = 0.f;
                    bf16x8 fb[8];
                    __builtin_amdgcn_sched_barrier(0);
#pragma unroll
                    for (int ds = 0; ds < 8; ++ds) { const LAS unsigned char* qp = L + O_QH + (hk * CL + 32 * ni + r32) * PQ + (16 * ds + 4 * h) * 2;
                        const u32x2 lo = *(const LAS u32x2*)qp, hi = *(const LAS u32x2*)(qp + 16); fb[ds] = __builtin_bit_cast(bf16x8, (u32x4){lo.x, lo.y, hi.x, hi.y}); }
                    __builtin_amdgcn_sched_barrier(0);
#pragma unroll
                    for (int ds = 0; ds < 8; ++ds) { const int dt = ds >> 1, s = ds & 1; u32x4 p;
#pragma unroll
                        for (int e = 0; e < 4; ++e) p[e] = pk2(S[dt][8 * s + 2 * e], S[dt][8 * s + 2 * e + 1]);
                        oT[ni] = MFMA32(__builtin_bit_cast(bf16x8, p), fb[ds], oT[ni]); }
                    __builtin_amdgcn_sched_barrier(0);
                    if constexpr (MODE == 2) { const float e = __expf(((LAS float*)(L + O_BS))[hs * 64 + 32 * ni + r32]);
#pragma unroll
                        for (int r = 0; r < 16; ++r) oT[ni][r] *= e; }
                }
                }
                __syncthreads();
                { LAUNDER();
                const int ha = (MODE == 0) ? 0 : (MODE == 1 ? (w >> 2) : (w >> 1));
#pragma unroll
                for (int ni = 0; ni < NI; ++ni) { bf16x8 fa[2 * (NI)], fb[2 * (NI)];
                    __builtin_amdgcn_sched_barrier(0);
#pragma unroll
                    for (int s = 0; s < 2 * (ni + 1); ++s) { fa[s] = *(const LAS bf16x8*)(L + O_VT + (32 * w + r32) * PJ + (16 * s + 8 * h) * 2);
                        fb[s] = *(const LAS bf16x8*)(L + O_ATT + (ha * CL + 32 * ni + r32) * PJ + (16 * s + 8 * h) * 2); }
                    __builtin_amdgcn_sched_barrier(0);
#pragma unroll
                    for (int s = 0; s < 2 * (ni + 1); ++s) oT[ni] = MFMA32(fa[s], fb[s], oT[ni]);
                    __builtin_amdgcn_sched_barrier(0); }
                }
            }
            { LAUNDER();
            if constexpr (MODE == 2) { const float dsc = ((LAS float*)(L + O_DEC))[hs];
#pragma unroll
                for (int dt = 0; dt < 4; ++dt)
#pragma unroll
                    for (int r = 0; r < 16; ++r) S[dt][r] *= dsc; }
#pragma unroll
            for (int s = 0; s < CL / 16; ++s) { bf16x8 B, A[4]; float wj[8];
                __builtin_amdgcn_sched_barrier(0);
                B = *(const LAS bf16x8*)(L + O_VT + (32 * w + r32) * PJ + (16 * s + 8 * h) * 2);
#pragma unroll
                for (int dt = 0; dt < 4; ++dt) A[dt] = *(const LAS bf16x8*)(L + O_KT + (hk * 128 + 32 * dt + r32) * PJ + (16 * s + 8 * h) * 2);
                if constexpr (MODE == 2) { const f32x4 wa = *(const LAS f32x4*)(L + O_WJ + (hs * 64 + 16 * s + 8 * h) * 4), wb = *(const LAS f32x4*)(L + O_WJ + (hs * 64 + 16 * s + 8 * h + 4) * 4);
#pragma unroll
                    for (int e = 0; e < 4; ++e) { wj[e] = wa[e]; wj[4 + e] = wb[e]; } }
                __builtin_amdgcn_sched_barrier(0);
#pragma unroll
                for (int dt = 0; dt < 4; ++dt) {
                    if constexpr (MODE == 2) { const u32x4 ap = __builtin_bit_cast(u32x4, A[dt]); u32x4 o;
#pragma unroll
                        for (int e = 0; e < 4; ++e) o[e] = pk2(bflo(ap[e]) * wj[2 * e], bfhi(ap[e]) * wj[2 * e + 1]);
                        A[dt] = __builtin_bit_cast(bf16x8, o); }
                    S[dt] = MFMA32(A[dt], B, S[dt]); }
                __builtin_amdgcn_sched_barrier(0); }
            if constexpr (MODE != 2) {
#pragma unroll
                for (int dt = 0; dt < 4; ++dt)
#pragma unroll
                    for (int q = 0; q < 4; ++q) { const f32x4 f = *(const LAS f32x4*)(L + O_DEC + (hk * 128 + 32 * dt + crow(4 * q, h)) * 4);
#pragma unroll
                        for (int e = 0; e < 4; ++e) S[dt][4 * q + e] *= f[e]; } }
            }
            if constexpr (PHASE == 1) { LAUNDER();
                float part[NI];
                if constexpr (MODE == 2) {
                    const int head = 4 * hx + hs; const float Dh = a.in[25][head];
#pragma unroll
                    for (int ni = 0; ni < NI; ++ni) { const int i = 32 * ni + r32; const size_t tok = tok0 + i; float ss = 0.f;
#pragma unroll
                        for (int q = 0; q < 4; ++q) { const int vv = 32 * w + crow(4 * q, h), p0 = 32 * (w & 1) + crow(4 * q, h);
                            const u32x2 zz = *(const u32x2*)((const bf16_t*)(act + A1_SZ) + tok * 1024 + head * 64 + p0);
                            const float zf[4] = {bflo(zz.x), bfhi(zz.x), bflo(zz.y), bfhi(zz.y)}; float o[4];
#pragma unroll
                            for (int e = 0; e < 4; ++e) { const float xs = bf2f(*(const LAS unsigned short*)(L + O_VT + (vv + e) * PJ + i * 2));
                                o[e] = (oT[ni][4 * q + e] + Dh * xs) * siluf_(zf[e]); ss += o[e] * o[e]; }
                            *(u32x2*)((bf16_t*)(ws + WS_CONCAT) + tok * 2048 + head * 64 + p0) = (u32x2){pk2(o[0], o[1]), pk2(o[2], o[3])}; }
                        ss += __shfl_xor(ss, 32); part[ni] = ss;
                        if (h == 0) ((LAS float*)(L + O_RED))[w * 64 + i] = ss; }
                    __syncthreads();
                    if ((w & 1) == 0 && h == 0) {
#pragma unroll
                        for (int ni = 0; ni < NI; ++ni) { const int i = 32 * ni + r32; ((float*)(ws + WS_SSQ))[(tok0 + i) * 16 + head] = part[ni] + ((LAS float*)(L + O_RED))[(w + 1) * 64 + i]; } }
                } else {
#pragma unroll
                    for (int ni = 0; ni < NI; ++ni) { float ss = 0.f;
#pragma unroll
                        for (int r = 0; r < 16; ++r) ss += oT[ni][r] * oT[ni][r];
                        ss += __shfl_xor(ss, 32); if (h == 0) ((LAS float*)(L + O_RED))[w * 64 + 32 * ni + r32] = ss; }
                    __syncthreads();
#pragma unroll
                    for (int ni = 0; ni < NI; ++ni) { const int i = 32 * ni + r32; const size_t tok = tok0 + i; float tot = 0.f;
                        if constexpr (MODE == 0) {
#pragma unroll
                            for (int ww = 0; ww < 8; ++ww) tot += ((LAS float*)(L + O_RED))[ww * 64 + i];
                        } else {
#pragma unroll
                            for (int ww = 0; ww < 4; ++ww) tot += ((LAS float*)(L + O_RED))[((w & 4) + ww) * 64 + i];
                        }
                        const float rs = 1.0f / sqrtf(tot * (MODE == 0 ? 1.0f / 256.0f : 1.0f / 128.0f) + EPS);
#pragma unroll
                        for (int q = 0; q < 4; ++q) {
                            const int vv = 32 * w + crow(4 * q, h);
                            const int vh = (MODE == 0) ? vv : (vv & 127);
                            const float* nw = (MODE == 0 ? a.in[10] : a.in[20]) + vh;
                            const bf16_t* gp = (MODE == 0) ? (const bf16_t*)(act + A0_GZ) + tok * 1024 + hx * 256 + vv : (const bf16_t*)(act + A1_HZ) + tok * 1024 + hx * 256 + vv;
                            const u32x2 zz = *(const u32x2*)gp; const float zf[4] = {bflo(zz.x), bfhi(zz.x), bflo(zz.y), bfhi(zz.y)}; float o[4];
#pragma unroll
                            for (int e = 0; e < 4; ++e) o[e] = oT[ni][4 * q + e] * rs * nw[e] * siluf_(zf[e]);
                            bf16_t* dst = (bf16_t*)(ws + WS_CONCAT) + tok * 2048 + (MODE == 0 ? 0 : 1024) + hx * 256 + vv;
                            *(u32x2*)dst = (u32x2){pk2(o[0], o[1]), pk2(o[2], o[3])}; } }
                }
            }
            __syncthreads();
        }
        if constexpr (PHASE == 0) { LAUNDER();
            float* U = Ubase + (size_t)item * 32768 + (size_t)w * 4096 + lane;
#pragma unroll
            for (int dt = 0; dt < 4; ++dt)
#pragma unroll
                for (int r = 0; r < 16; ++r) U[(dt * 16 + r) * 64] = S[dt][r];
            if (tid < 256) LOGD[(size_t)item * 256 + tid] = ((LAS float*)(L + O_LS))[tid];
        }
        __syncthreads();
    }
}
#undef LAUNDER
#undef STG_LOAD
#undef STG_STORE
constexpr int NSA_KP = 272, NSA_VP = 144;
constexpr int NL_K = 0, NL_V = NL_K + 64 * NSA_KP, NL_BUF = NL_V + 128 * NSA_VP  , NL_IMP = 2 * NL_BUF, NL_SEL = NL_IMP + 2 * 8 * 8 * 132 * 4, NL_QI = NL_SEL + 64 * 16, NL_END = NL_QI + 64;
static_assert(NL_END <= RING_BYTES, "NSA LDS");
constexpr float NEG_BIG = -1e30f;

struct NsaTile { u32x4 k0, k1, v0, v1; };
DI void nsa_tile_load(NsaTile& T, const bf16_t* Kg  , const bf16_t* Vg  , int ldv, int t, int tid) {
    const int c0 = tid, c1 = tid + 512;
    T.k0 = *(const u32x4*)(Kg + (size_t)(64 * t + (c0 >> 4)) * 128 + (c0 & 15) * 8);
    T.k1 = *(const u32x4*)(Kg + (size_t)(64 * t + (c1 >> 4)) * 128 + (c1 & 15) * 8);
    T.v0 = *(const u32x4*)(Vg + (size_t)(c0 >> 3) * ldv + 64 * t + (c0 & 7) * 8);
    T.v1 = *(const u32x4*)(Vg + (size_t)(c1 >> 3) * ldv + 64 * t + (c1 & 7) * 8);
}
DI void nsa_tile_store(const NsaTile& T, LAS unsigned char* L  , int tid) {
    const int c0 = tid, c1 = tid + 512;
    *(LAS u32x4*)(L + NL_K + (c0 >> 4) * NSA_KP + (c0 & 15) * 16) = T.k0;
    *(LAS u32x4*)(L + NL_K + (c1 >> 4) * NSA_KP + (c1 & 15) * 16) = T.k1;
    *(LAS u32x4*)(L + NL_V + (c0 >> 3) * NSA_VP + (c0 & 7) * 16) = T.v0;
    *(LAS u32x4*)(L + NL_V + (c1 >> 3) * NSA_VP + (c1 & 7) * 16) = T.v1;
}
DI void nsa_scores(f32x16 (&sT)[2], const bf16x8 (&qf)[8], LAS unsigned char* L, int r32, int h) {
#pragma unroll
    for (int mt = 0; mt < 2; ++mt) {
#pragma unroll
        for (int r = 0; r < 16; ++r) sT[mt][r] = 0.f;
#pragma unroll
        for (int s = 0; s < 8; ++s) { const bf16x8 A = *(const LAS bf16x8*)(L + NL_K + (32 * mt + r32) * NSA_KP + (16 * s + 8 * h) * 2); sT[mt] = MFMA32(A, qf[s], sT[mt]); }
    }
}
struct NsaState { f32x16 O[4]; float m, l; };
template <int BR> DI bool nsa_valid(int kk  , int tq  , int t, int qb, bool lane_sel) {
    if constexpr (BR == 0) return (16 * kk + 31 <= tq) && (kk <= 510);
    else if constexpr (BR == 1) return lane_sel && (kk <= tq);
    else return (kk <= tq) && (kk > tq - 512);
}
constexpr float NSA_THR = 10.0f;
DI bf16x8 nsa_ldk(LAS unsigned char* L, int mt, int s, int r32, int h) { return *(const LAS bf16x8*)(L + NL_K + (32 * mt + r32) * NSA_KP + (16 * s + 8 * h) * 2); }
DI bf16x8 nsa_ldv(LAS unsigned char* L, int dt, int g  , int r32, int h) {
    const LAS unsigned char* vp = L + NL_V + (32 * dt + r32) * NSA_VP + (16 * g + 4 * h) * 2;
    const u32x2 lo = *(const LAS u32x2*)vp, hi = *(const LAS u32x2*)(vp + 16);
    return __builtin_bit_cast(bf16x8, (u32x4){lo.x, lo.y, hi.x, hi.y});
}
template <int BR> DI void nsa_tile_compute(NsaState& st, const bf16x8 (&qf)[8], LAS unsigned char* L, int t, int tq, bool lane_sel, bool edge, int r32, int h) {
    f32x16 sT[2];
    const float nm = -st.m;
#pragma unroll
    for (int mt = 0; mt < 2; ++mt)
#pragma unroll
        for (int r = 0; r < 16; ++r) sT[mt][r] = nm;
    bf16x8 ka[8], kb[8];
    __builtin_amdgcn_sched_barrier(0);
#pragma unroll
    for (int s = 0; s < 8; ++s) ka[s] = nsa_ldk(L, 0, s, r32, h);
    __builtin_amdgcn_sched_barrier(0);
#pragma unroll
    for (int s = 0; s < 8; ++s) { kb[s] = nsa_ldk(L, 1, s, r32, h); sT[0] = MFMA32(ka[s], qf[s], sT[0]); }
    __builtin_amdgcn_sched_barrier(0);
    bf16x8 va[4], vb[4];
#pragma unroll
    for (int s = 0; s < 8; ++s) { if (s < 4) va[s] = nsa_ldv(L, s, 0, r32, h); sT[1] = MFMA32(kb[s], qf[s], sT[1]); }
    __builtin_amdgcn_sched_barrier(0);
    if (edge) {
#pragma unroll
        for (int mt = 0; mt < 2; ++mt)
#pragma unroll
            for (int r = 0; r < 16; ++r) { const int kk = 64 * t + 32 * mt + crow(r, h); const bool ok = nsa_valid<BR>(kk, tq, t, 0, true); sT[mt][r] = ok ? sT[mt][r] : NEG_BIG; }
    }
    float rm = fmaxf(sT[0][0], sT[1][0]);
#pragma unroll
    for (int r = 1; r < 16; ++r) rm = fmaxf(rm, fmaxf(sT[0][r], sT[1][r]));
    rm = fmaxf(rm, __shfl_xor(rm, 32));
    if constexpr (BR == 1) { if (!lane_sel) rm = NEG_BIG; }
    if (__any(rm > NSA_THR)) {
        const float dl = fmaxf(rm, 0.f), alpha = fast_exp2(-dl);
        st.m += dl; st.l *= alpha;
#pragma unroll
        for (int mt = 0; mt < 2; ++mt)
#pragma unroll
            for (int r = 0; r < 16; ++r) sT[mt][r] -= dl;
#pragma unroll
        for (int dt = 0; dt < 4; ++dt)
#pragma unroll
            for (int r = 0; r < 16; ++r) st.O[dt][r] *= alpha;
    }
    float ps = 0.f;
#pragma unroll
    for (int g = 0; g < 4; ++g) { const int mt = g >> 1, s = g & 1; u32x4 pk;
#pragma unroll
        for (int e = 0; e < 4; ++e) { unsigned w = pk2(fast_exp2(sT[mt][8 * s + 2 * e]), fast_exp2(sT[mt][8 * s + 2 * e + 1]));
            if constexpr (BR == 1) w = lane_sel ? w : 0u;
            ps = __builtin_amdgcn_fdot2_f32_bf16(__builtin_bit_cast(bf16x2_t, w), __builtin_bit_cast(bf16x2_t, 0x3f803f80u), ps, false);
            pk[e] = w; }
        const bf16x8 B = __builtin_bit_cast(bf16x8, pk);
        __builtin_amdgcn_sched_barrier(0);
        if ((g & 1) == 0) {
#pragma unroll
            for (int dt = 0; dt < 4; ++dt) { vb[dt] = nsa_ldv(L, dt, g + 1, r32, h); st.O[dt] = MFMA32(va[dt], B, st.O[dt]); }
        } else {
#pragma unroll
            for (int dt = 0; dt < 4; ++dt) { if (g < 3) va[dt] = nsa_ldv(L, dt, g + 1, r32, h); st.O[dt] = MFMA32(vb[dt], B, st.O[dt]); }
        }
        __builtin_amdgcn_sched_barrier(0);
    }
    st.l += ps;
}
template <int BR> DI void nsa_branch(NsaState& st, const bf16x8 (&qf)[8], LAS unsigned char* L, const bf16_t* Kg, const bf16_t* Vg, int ldv, int t_lo, int t_hi, int qb, int tq, const u32x4& selw, int tid0) {
#pragma unroll
    for (int dt = 0; dt < 4; ++dt)
#pragma unroll
        for (int r = 0; r < 16; ++r) st.O[dt][r] = 0.f;
    st.m = 0.f; st.l = 0.f;
    NsaTile T;
    { int tid = tid0; asm volatile("" : "+v"(tid)); nsa_tile_load(T, Kg, Vg, ldv, t_lo, tid);
        __syncthreads();
        nsa_tile_store(T, L + (t_lo & 1) * NL_BUF, tid);
        if (t_lo < t_hi) nsa_tile_load(T, Kg, Vg, ldv, t_lo + 1, tid);
        __syncthreads(); }
#pragma unroll 1
    for (int t = t_lo; t <= t_hi; ++t) {
        int tid = tid0; asm volatile("" : "+v"(tid)); const int lane = tid & 63, r32 = lane & 31, h = lane >> 5;
        if (t < t_hi) nsa_tile_store(T, L + ((t + 1) & 1) * NL_BUF, tid);
        if (t + 1 < t_hi) nsa_tile_load(T, Kg, Vg, ldv, t + 2, tid);
        bool lane_sel = true, edge;
        if constexpr (BR == 0) edge = (1024 * t + 1039 > 64 * qb) || (t == 7);
        else if constexpr (BR == 1) { edge = (t == qb); const unsigned wsel = (t < 32) ? selw.x : (t < 64) ? selw.y : (t < 96) ? selw.z : selw.w; lane_sel = (wsel >> (t & 31)) & 1u; }
        else edge = (t == qb) || (t + 8 == qb);
        if (BR != 1 || __any(lane_sel)) nsa_tile_compute<BR>(st, qf, L + (t & 1) * NL_BUF, t, tq, lane_sel, edge, r32, h);
        __syncthreads();
    }
}
template <int RMW> DI void nsa_flush(const NsaState& st, bf16_t* OW, size_t tok, int head, float gate, int lane) {
    const int h = lane >> 5;
    float lt = st.l + __shfl_xor(st.l, 32);
    const float sc = (lt > 0.f) ? gate / lt : 0.f;
#pragma unroll
    for (int dt = 0; dt < 4; ++dt)
#pragma unroll
        for (int q = 0; q < 4; ++q) { bf16_t* p = OW + tok * 1024 + head * 128 + 32 * dt + crow(4 * q, h);
            float o[4];
#pragma unroll
            for (int e = 0; e < 4; ++e) o[e] = st.O[dt][4 * q + e] * sc;
            if constexpr (RMW) { const u32x2 old = *(const u32x2*)p; o[0] += bflo(old.x); o[1] += bfhi(old.x); o[2] += bflo(old.y); o[3] += bfhi(old.y); }
            *(u32x2*)p = (u32x2){pk2(o[0], o[1]), pk2(o[2], o[3])}; }
}
DI void nsa_load_q(bf16x8 (&qf)[8], const bf16_t* NQ, size_t tok, int head, int h) {
#pragma unroll
    for (int s = 0; s < 8; ++s) qf[s] = *(const bf16x8*)(NQ + tok * 1024 + head * 128 + 16 * s + 8 * h);
}
DI void nsa_win_item(const Frame& F, CArgs& a, int item) {
    unsigned char* act = a.ws + WS_ACT; LAS unsigned char* L = F.lds;
    const int qb = item >> 2, bg = item & 3, b = bg >> 1, g = bg & 1;
    const int lane = F.lane, r32 = lane & 31, h = lane >> 5, w = F.wave;
    const int ti = 8 * w + (r32 >> 2), j = r32 & 3, head = g * 4 + j, tq = 64 * qb + ti; const size_t tok = (size_t)b * SEQ + tq;
    bf16x8 qf[8]; nsa_load_q(qf, (const bf16_t*)(act + A0_NQ), tok, head, h);
    NsaState st; const u32x4 nosel = {0u, 0u, 0u, 0u};
    nsa_branch<2>(st, qf, L, (const bf16_t*)(act + A0_NKW) + (size_t)bg * SEQ * 128, (const bf16_t*)(act + A0_NVWT) + (size_t)bg * 128 * SEQ, SEQ, qb >= 8 ? qb - 8 : 0, qb, qb, tq, nosel, F.tid);
    const float gate = ((const float*)(act + A0_NGATE))[tok * 24 + head * 3 + 2];
    nsa_flush<0>(st, (bf16_t*)(a.ws + WS_OW), tok, head, gate, lane);
}
DI void nsa_main_item(const Frame& F, CArgs& a, int item) {
    unsigned char* act = a.ws + WS_ACT; LAS unsigned char* L = F.lds;
    const int qb = item >> 2, bg = item & 3, b = bg >> 1, g = bg & 1;
    const int lane = F.lane, r32 = lane & 31, h = lane >> 5, w = F.wave;
    const int ti = 8 * w + (r32 >> 2), j = r32 & 3, head = g * 4 + j, tq = 64 * qb + ti; const size_t tok = (size_t)b * SEQ + tq;
    bf16x8 qf[8]; nsa_load_q(qf, (const bf16_t*)(act + A0_NQ), tok, head, h);
    const bf16_t* KC = (const bf16_t*)(a.ws + WS_KC) + (size_t)bg * 512 * 128; const bf16_t* VCT = (const bf16_t*)(a.ws + WS_VCT) + (size_t)bg * 128 * 512;
    const float* gates = (const float*)(act + A0_NGATE) + tok * 24 + head * 3;
    NsaState st; const u32x4 nosel = {0u, 0u, 0u, 0u};
    const int tc_hi = (4 * qb + 2) >> 6;
    nsa_branch<0>(st, qf, L, KC, VCT, 512, 0, tc_hi, qb, tq, nosel, F.tid);
    nsa_flush<0>(st, (bf16_t*)(a.ws + WS_OC), tok, head, gates[0], lane);
    LAS float* IMP = (LAS float*)(L + NL_IMP) + w * 2 * 8 * 132;
    LAS unsigned* SEL = (LAS unsigned*)(L + NL_SEL);
    u32x4 selw;
    if (qb >= 16) {
        const float mfin = st.m; float lt = st.l + __shfl_xor(st.l, 32); const float linv = lt > 0.f ? 1.0f / lt : 0.f;
        for (int e = lane; e < 2 * 8 * 132; e += 64) IMP[e] = 0.f;
        NsaTile T; nsa_tile_load(T, KC, VCT, 512, 0, F.tid);
#pragma unroll 1
        for (int t = 0; t <= tc_hi; ++t) {
            int tidl = F.tid; asm volatile("" : "+v"(tidl)); const int lane = tidl & 63, r32 = lane & 31, h = lane >> 5, j = r32 & 3;
            __syncthreads(); nsa_tile_store(T, L, tidl); __syncthreads();
            if (t < tc_hi) nsa_tile_load(T, KC, VCT, 512, t + 1, tidl);
            f32x16 sT[2]; nsa_scores(sT, qf, L, r32, h);
#pragma unroll
            for (int mt = 0; mt < 2; ++mt)
#pragma unroll
                for (int q = 0; q < 4; ++q) { float p[4];
#pragma unroll
                    for (int e = 0; e < 4; ++e) { const int n = 64 * t + 32 * mt + crow(4 * q + e, h); const bool ok = (16 * n + 31 <= tq) && (n <= 510);
                        p[e] = ok ? fast_exp2(sT[mt][4 * q + e] - mfin) * linv : 0.f; }
                    float qs = (p[0] + p[1]) + (p[2] + p[3]), p3 = p[3];
                    qs += __shfl_xor(qs, 1); qs += __shfl_xor(qs, 2); p3 += __shfl_xor(p3, 1); p3 += __shfl_xor(p3, 2);
                    const int ablk = 16 * t + 8 * mt + 2 * q + h;
                    if (j == 0) { IMP[(r32 >> 2) * 132 + ablk] = qs; IMP[8 * 132 + (r32 >> 2) * 132 + ablk + 1] = p3; } }
        }
        __syncthreads();
        { int tidl = F.tid; asm volatile("" : "+v"(tidl)); const int lane = tidl & 63; const int tl = lane >> 3, sub = lane & 7;
            unsigned key[16];
#pragma unroll
            for (int u = 0; u < 16; ++u) { const int s = 1 + sub + 8 * u; const int sx = (s < 128 ? s : 127); const float v = IMP[tl * 132 + sx] + IMP[8 * 132 + tl * 132 + sx];
                key[u] = (s <= qb - 2) ? ((__float_as_uint(v) & ~127u) | (unsigned)(127 - s)) + 128u : 0u; }
            unsigned pre = 0u;
#pragma unroll 1
            for (int bit = 31; bit >= 0; --bit) { const unsigned trial = pre | (1u << bit); int c = 0;
#pragma unroll
                for (int u = 0; u < 16; ++u) c += (key[u] >= trial) ? 1 : 0;
                c += __shfl_xor(c, 1); c += __shfl_xor(c, 2); c += __shfl_xor(c, 4);
                if (c >= 13) pre = trial; }
            unsigned m0 = 0u, m1 = 0u, m2 = 0u, m3 = 0u;
#pragma unroll
            for (int u = 0; u < 16; ++u) { const int s = 1 + sub + 8 * u; if (key[u] >= pre && key[u] != 0u) { const unsigned bitv = 1u << (s & 31);
                    if (s < 32) m0 |= bitv; else if (s < 64) m1 |= bitv; else if (s < 96) m2 |= bitv; else m3 |= bitv; } }
#pragma unroll
            for (int o = 1; o < 8; o <<= 1) { m0 |= __shfl_xor(m0, o); m1 |= __shfl_xor(m1, o); m2 |= __shfl_xor(m2, o); m3 |= __shfl_xor(m3, o); }
            m0 |= 1u;
            { const int s1 = qb, s2 = qb - 1; const unsigned b1 = 1u << (s1 & 31), b2 = 1u << (s2 & 31);
                if (s1 < 32) m0 |= b1; else if (s1 < 64) m1 |= b1; else if (s1 < 96) m2 |= b1; else m3 |= b1;
                if (s2 < 32) m0 |= b2; else if (s2 < 64) m1 |= b2; else if (s2 < 96) m2 |= b2; else m3 |= b2; }
            if (sub == 0) { SEL[(8 * w + tl) * 4 + 0] = m0; SEL[(8 * w + tl) * 4 + 1] = m1; SEL[(8 * w + tl) * 4 + 2] = m2; SEL[(8 * w + tl) * 4 + 3] = m3; }
        }
        __syncthreads();
        selw = *(LAS u32x4*)(SEL + ti * 4);
    } else {
        selw = (u32x4){0xffffffffu, 0xffffffffu, 0xffffffffu, 0xffffffffu};
    }
    nsa_branch<1>(st, qf, L, (const bf16_t*)(act + A0_NKS) + (size_t)bg * SEQ * 128, (const bf16_t*)(act + A0_NVST) + (size_t)bg * 128 * SEQ, SEQ, 0, qb, qb, tq, selw, F.tid);
    { float lt = st.l + __shfl_xor(st.l, 32); const float sc = (lt > 0.f) ? gates[1] / lt : 0.f;
        const bf16_t* OW = (const bf16_t*)(a.ws + WS_OW) + tok * 1024 + head * 128; const bf16_t* OC = (const bf16_t*)(a.ws + WS_OC) + tok * 1024 + head * 128; const bf16_t* NZ = (const bf16_t*)(act + A0_NZ) + tok * 1024 + head * 128;
        bf16_t* CC = (bf16_t*)(a.ws + WS_CONCAT) + tok * 2048 + 1024 + head * 128;
#pragma unroll
        for (int dt = 0; dt < 4; ++dt)
#pragma unroll
            for (int q = 0; q < 4; ++q) { const int d0 = 32 * dt + crow(4 * q, h);
                const u32x2 ow = *(const u32x2*)(OW + d0), oc = *(const u32x2*)(OC + d0), nz = *(const u32x2*)(NZ + d0);
                const float o0 = (st.O[dt][4 * q + 0] * sc + bflo(ow.x) + bflo(oc.x)) * siluf_(bflo(nz.x)), o1 = (st.O[dt][4 * q + 1] * sc + bfhi(ow.x) + bfhi(oc.x)) * siluf_(bfhi(nz.x));
                const float o2 = (st.O[dt][4 * q + 2] * sc + bflo(ow.y) + bflo(oc.y)) * siluf_(bflo(nz.y)), o3 = (st.O[dt][4 * q + 3] * sc + bfhi(ow.y) + bfhi(oc.y)) * siluf_(bfhi(nz.y));
                *(u32x2*)(CC + d0) = (u32x2){pk2(o0, o1), pk2(o2, o3)}; } }
    __syncthreads();
}
DI void nsa_compress_finish(const Frame& F, CArgs& a) {
    LAS float* HID = (LAS float*)F.lds;
    LAS float* B1 = (LAS float*)(F.lds + 8192);
    const float* P = (const float*)(a.ws + WS_CONCAT);
    for (int it = F.bid; it < 2 * 256; it += F.G) {
        const int job = it >> 8, r0 = (it & 255) * 8;
        __syncthreads();
        if (F.tid < 256) { float s = 0.f;
#pragma unroll 16
            for (int j = 0; j < 64; ++j) s += ((const float*)(a.ws + WS_B1P))[(size_t)(job * 64 + j) * 256 + F.tid];
            B1[F.tid] = s; }
        __syncthreads();
        for (int e = F.tid; e < 8 * 256; e += NTHR) { const int rr = e >> 8, cidx = e & 255; float s = B1[cidx];
#pragma unroll
            for (int ks = 0; ks < 8; ++ks) s += P[((size_t)(job * 8 + ks) * 2048 + r0 + rr) * 256 + cidx];
            HID[e] = siluf_(s); }
        __syncthreads();
        const float* w2 = a.in[job ? 16 : 13];
        for (int e = F.tid; e < 8 * 128; e += NTHR) { const int rr = e >> 7, o = e & 127; const int row = r0 + rr, bg = row >> 9, n = row & 511;
            const int dsrc = job ? o : dperm(o);
            float s = 0.f;
float s1 = 0.f, s2 = 0.f, s3 = 0.f;
#pragma unroll 8
            for (int cidx = 0; cidx < 256; cidx += 4) { s += HID[rr * 256 + cidx] * w2[cidx * 128 + dsrc]; s1 += HID[rr * 256 + cidx + 1] * w2[(cidx + 1) * 128 + dsrc]; s2 += HID[rr * 256 + cidx + 2] * w2[(cidx + 2) * 128 + dsrc]; s3 += HID[rr * 256 + cidx + 3] * w2[(cidx + 3) * 128 + dsrc]; }
            s = (s + s1) + (s2 + s3);
            if (n == 511) s = 0.f;
            if (job == 0) ((bf16_t*)(a.ws + WS_KC))[((size_t)bg * 512 + n) * 128 + o] = (bf16_t)f2bf(s);
            else ((bf16_t*)(a.ws + WS_VCT))[((size_t)bg * 128 + o) * 512 + n] = (bf16_t)f2bf(s); }
    }
    __syncthreads();
}
DI unsigned queue_next(const Frame& F, unsigned* ctr) {
    __syncthreads();
    if (F.tid == 0) *(LAS unsigned*)(F.lds + NL_QI) = __hip_atomic_fetch_add(ctr, 1u, __ATOMIC_RELAXED, __HIP_MEMORY_SCOPE_AGENT);
    __syncthreads();
    return *(LAS unsigned*)(F.lds + NL_QI);
}
__global__ void __launch_bounds__(NTHR, 2) trunk_fwd(Args args_unused) {
    extern __shared__ __attribute__((aligned(16))) unsigned char lds_raw[];
    Frame F;
    F.lds = (LAS unsigned char*)lds_raw;
    F.tid = threadIdx.x; F.lane = F.tid & 63; F.wave = __builtin_amdgcn_readfirstlane(F.tid >> 6);
    F.G = gridDim.x; F.bid = blockIdx.x;
    volatile LAS unsigned* MISC = (volatile LAS unsigned*)(F.lds + MISC_OFF);
    CArgs* ap0 = (CArgs*)__builtin_amdgcn_kernarg_segment_ptr();
    unsigned* ctl = (unsigned*)(ap0->ws + WS_CTL);
    for (int u = F.tid; u < (LDS_BYTES - LDSCTL_OFF) / 4; u += NTHR) ((LAS unsigned*)(F.lds + LDSCTL_OFF))[u] = 0u;
    __syncthreads();
    XcdBarrier bar = xcd_barrier_post(ctl + CW_BAR, MISC + 8);
    const int lo = ap0->ph_lo, hi = ap0->ph_hi;
#ifdef ONLY
#define IN(k) ((k) == ONLY && lo <= (k) && (k) < hi)
#else
#define IN(k) (lo <= (k) && (k) < hi)
#endif
#define GRID_BAR() xcd_barrier(bar)
#ifndef PROBE_DUP
#define PROBE_DUP -1
#endif
#define REP(k) for (int rep_ = 0; rep_ < ((k) == PROBE_DUP ? 2 : 1); ++rep_)
#define PHASE_ARGS() CArgs* ap = ap0; asm volatile("" : "+s"(ap)); CArgs& args = *ap; unsigned char* ws = args.ws; (void)ws
    if (IN(0)) REP(0) { PHASE_ARGS(); p0_prologue(F, args); GRID_BAR(); }
    if (IN(1)) REP(1) { PHASE_ARGS(); p1_prenorm0(F, args); GRID_BAR(); }
    if (IN(2)) REP(2) { PHASE_ARGS();
        pg8::Gemm g; g.A[0] = (const bf16_t*)(ws + WS_HY); g.Bt[0] = (const bf16_t*)(ws + WS_WN0); g.nM[0] = MTOK / 256; g.nN[0] = NN0 / 256; g.nK[0] = 1;
        g.A[1] = (const bf16_t*)(ws + WS_WT0); g.Bt[1] = (const bf16_t*)(ws + WS_HY); g.nM[1] = NT0 / 256; g.nN[1] = MTOK / 256; g.nK[1] = 1; g.lda = DM; g.ldb = DM; g.Klen = DM; g.chain = 0;
        pg8::MultiOrder S; S.init(g, F.G, F.bid); EpiProj<0> E{ws};
        pg8::gemm_phase<EpiProj<0>>(F.lds, g, S, E);
        GRID_BAR();
    }
    if (IN(3)) REP(3) { PHASE_ARGS();
        const int half = F.G / 2;
        if (F.bid >= half) {
            pg8::Gemm g; g.A[0] = (const bf16_t*)(ws + WS_ACT + A0_NKC); g.Bt[0] = (const bf16_t*)(ws + WS_W1K); g.nM[0] = 8; g.nN[0] = 1; g.nK[0] = 8;
            g.A[1] = (const bf16_t*)(ws + WS_ACT + A0_NVC); g.Bt[1] = (const bf16_t*)(ws + WS_W1V); g.nM[1] = 8; g.nN[1] = 1; g.nK[1] = 8; g.lda = 2048; g.ldb = 4096; g.Klen = 512; g.chain = 0;
            pg8::MultiOrder S; S.init(g, F.G - half, F.bid - half); EpiF32Part E{(float*)(ws + WS_CONCAT)};
            pg8::gemm_phase<EpiF32Part>(F.lds, g, S, E);
        }
        unsigned* qctr = (unsigned*)(ws + WS_CTL) + 2048 + 128 + 64 * rep_;
        for (;;) { const unsigned idx = queue_next(F, qctr); if (idx >= 1024u) break; la_prep<0>(F, args, (int)idx); }
        GRID_BAR();
    }
    if (IN(4)) REP(4) { PHASE_ARGS();
        const int half = F.G / 2;
        if (F.bid < half) la_phase<0, 0>(F, args, F.bid, half);
        nsa_compress_finish(F, args);
        unsigned* qctr = (unsigned*)(ws + WS_CTL) + 2048 + 256 + 64 * rep_;
        for (;;) { const unsigned idx = queue_next(F, qctr); if (idx >= 512u) break; nsa_win_item(F, args, 511 - (int)idx); }
        GRID_BAR();
    }
    if (IN(5)) REP(5) { PHASE_ARGS();
        const int half = F.G / 2;
        for (int r2 = 0; r2 < (PROBE_DUP == 50 ? 2 : 1); ++r2) if (F.bid < half) la_phase<0, 1>(F, args, F.bid, half);
        for (int r2 = 0; r2 < (PROBE_DUP == 51 ? 2 : 1); ++r2) {
        unsigned* qctr = (unsigned*)(ws + WS_CTL) + 2048 + 64 * rep_ + 512 * r2;
        for (;;) { const unsigned idx = queue_next(F, qctr); if (idx >= 512u) break; nsa_main_item(F, args, (127 - (int)(idx >> 2)) * 4 + (int)(idx & 3u)); }
        }
        GRID_BAR();
    }
    if (IN(6)) REP(6) { PHASE_ARGS();
        pg8::Gemm g; g.A[0] = (const bf16_t*)(ws + WS_CONCAT); g.Bt[0] = (const bf16_t*)(ws + WS_WO0); g.nM[0] = MTOK / 256; g.nN[0] = DM / 256; g.nK[0] = 1;
        g.A[1] = nullptr; g.Bt[1] = nullptr; g.nM[1] = 0; g.nN[1] = 0; g.nK[1] = 1; g.lda = DM; g.ldb = DM; g.Klen = DM; g.chain = 0;
        pg8::MultiOrder S; S.init(g, F.G, F.bid); EpiBf16 E{(bf16_t*)(ws + WS_HY), DM};
        pg8::gemm_phase<EpiBf16>(F.lds, g, S, E);
        GRID_BAR();
    }
    if (IN(7)) REP(7) { PHASE_ARGS(); p_residual<0>(F, args); GRID_BAR(); }
    if (IN(8)) REP(8) { PHASE_ARGS();
        pg8::Gemm g; g.A[0] = (const bf16_t*)(ws + WS_HY); g.Bt[0] = (const bf16_t*)(ws + WS_WN1); g.nM[0] = MTOK / 256; g.nN[0] = NN1 / 256; g.nK[0] = 1;
        g.A[1] = (const bf16_t*)(ws + WS_WT1); g.Bt[1] = (const bf16_t*)(ws + WS_HY); g.nM[1] = NT1 / 256; g.nN[1] = MTOK / 256; g.nK[1] = 1; g.lda = DM; g.ldb = DM; g.Klen = DM; g.chain = 0;
        pg8::MultiOrder S; S.init(g, F.G, F.bid); EpiProj<1> E{ws};
        pg8::gemm_phase<EpiProj<1>>(F.lds, g, S, E);
        GRID_BAR();
    }
    if (IN(9)) REP(9) { PHASE_ARGS();
        ssd_prep(F, args);
        for (int it = F.bid; it < 2048; it += F.G) la_prep<1>(F, args, it);
        GRID_BAR();
    }
    if (IN(10)) REP(10) { PHASE_ARGS();
        const int half = F.G / 2;
        if (F.bid < half) la_phase<1, 0>(F, args, F.bid, half); else la_phase<2, 0>(F, args, F.bid - half, F.G - half);
        GRID_BAR();
    }
    if (IN(11)) REP(11) { PHASE_ARGS();
        const int half = F.G / 2;
#if !defined(SKIP_H)
        if (F.bid < half) la_phase<1, 1>(F, args, F.bid, half);
#endif
#if !defined(SKIP_S)
        if (F.bid >= half) la_phase<2, 1>(F, args, F.bid - half, F.G - half);
#endif
        GRID_BAR();
    }
    if (IN(12)) REP(12) { PHASE_ARGS();
        pg8::Gemm g; g.A[0] = (const bf16_t*)(ws + WS_CONCAT); g.Bt[0] = (const bf16_t*)(ws + WS_WO1); g.nM[0] = MTOK / 256; g.nN[0] = DM / 256; g.nK[0] = 2;
        g.A[1] = nullptr; g.Bt[1] = nullptr; g.nM[1] = 0; g.nN[1] = 0; g.nK[1] = 1; g.lda = DM; g.ldb = DM; g.Klen = DM / 2; g.chain = 1;
        pg8::MultiOrder S; S.init(g, F.G, F.bid); EpiBf16Mid E{(bf16_t*)(ws + WS_HY), DM, (const float*)(ws + WS_RTAB)};
        { pg8::Unit u; for (int i = 0; S.next(i, u); ++i) if (F.tid < 256) { const int row = u.pm * 256 + F.tid; const f32x4* p = (const f32x4*)((const float*)(ws + WS_SSQ) + (size_t)row * 16);
                const f32x4 q0 = p[0], q1 = p[1], q2 = p[2], q3 = p[3];
                const float s = ((q0[0] + q0[1]) + (q0[2] + q0[3])) + ((q1[0] + q1[1]) + (q1[2] + q1[3])) + ((q2[0] + q2[1]) + (q2[2] + q2[3])) + ((q3[0] + q3[1]) + (q3[2] + q3[3]));
                ((float*)(ws + WS_RTAB))[row] = 1.0f / sqrtf(s * (1.0f / 1024.0f) + EPS); }
          asm volatile("s_waitcnt vmcnt(0)" ::: "memory"); __syncthreads(); }
        pg8::gemm_phase<EpiBf16Mid>(F.lds, g, S, E);
        GRID_BAR();
    }
    if (IN(13)) REP(13) { PHASE_ARGS(); p_residual<1>(F, args); }
#undef IN
#undef GRID_BAR
}

extern "C" void kernel_launch(void* const* d_in, const int* in_sizes, int n_in, void* d_out, int out_size, void* d_ws, size_t ws_size, hipStream_t stream) {
    static int grid = 0;
    if (grid == 0) {
        if (n_in != 27 || out_size != MTOK * DM || ws_size < WS_END) { fprintf(stderr, "kernel_launch: unexpected shapes (n_in %d, out %d, ws %zu < %zu)\n", n_in, out_size, ws_size, (size_t)WS_END); grid = -1; return; }
        int dev = 0, cus = 0;
        if (hipGetDevice(&dev) != hipSuccess || hipDeviceGetAttribute(&cus, hipDeviceAttributeMultiprocessorCount, dev) != hipSuccess) { grid = -1; return; }
        if (hipFuncSetAttribute((const void*)trunk_fwd, hipFuncAttributeMaxDynamicSharedMemorySize, LDS_BYTES) != hipSuccess) { fprintf(stderr, "kernel_launch: hipFuncSetAttribute failed\n"); grid = -1; return; }
        (void)hipGetLastError();
        grid = cus;
    }
    if (grid < 0) return;
    if (hipMemsetAsync((char*)d_ws + WS_CTL, 0, CTL_ZERO_BYTES, stream) != hipSuccess) return;
    Args a{};
    for (int i = 0; i < 27; ++i) a.in[i] = (const float*)d_in[i];
    a.out = (float*)d_out; a.ws = (unsigned char*)d_ws; a.ph_lo = 0; a.ph_hi = 14;
    hipLaunchKernelGGL(trunk_fwd, dim3(grid), dim3(NTHR), LDS_BYTES, stream, a);
}
```

```cpp
#include <hip/hip_runtime.h>
#include <cstdio>
#include <cstdint>

#define GAS __attribute__((address_space(1)))
#define LAS __attribute__((address_space(3)))
#define DI __device__ __forceinline__
typedef unsigned short bf16_t;
typedef short bf16x8 __attribute__((ext_vector_type(8)));
typedef short s16x4 __attribute__((ext_vector_type(4)));
typedef float f32x2 __attribute__((ext_vector_type(2)));
typedef float f32x4 __attribute__((ext_vector_type(4)));
typedef float f32x16 __attribute__((ext_vector_type(16)));
typedef unsigned u32x2 __attribute__((ext_vector_type(2)));
typedef unsigned u32x4 __attribute__((ext_vector_type(4)));
typedef __bf16 bf16x2_t __attribute__((ext_vector_type(2)));

DI unsigned f2bf(float f) { unsigned u = __builtin_bit_cast(unsigned, f); return (u + 0x7fffu + ((u >> 16) & 1u)) >> 16; }
DI float bf2f(unsigned short h) { return __builtin_bit_cast(float, (unsigned)h << 16); }
DI unsigned pk2(float lo, float hi) { f32x2 v = {lo, hi}; bf16x2_t b = __builtin_convertvector(v, bf16x2_t); return __builtin_bit_cast(unsigned, b); }
DI int dpp_i(int v, int ctrl_sel) { return ctrl_sel == 0 ? __builtin_amdgcn_update_dpp(0, v, 0xB1, 0xf, 0xf, true) : ctrl_sel == 1 ? __builtin_amdgcn_update_dpp(0, v, 0x4E, 0xf, 0xf, true) : __builtin_amdgcn_update_dpp(0, v, 0x141, 0xf, 0xf, true); }
DI float quad_sum(float v) {
    v += __builtin_bit_cast(float, __builtin_amdgcn_update_dpp(0, __builtin_bit_cast(int, v), 0xB1, 0xf, 0xf, true));
    v += __builtin_bit_cast(float, __builtin_amdgcn_update_dpp(0, __builtin_bit_cast(int, v), 0x4E, 0xf, 0xf, true));
    return v; }
DI int oct_sum(int v) {
    v += __builtin_amdgcn_update_dpp(0, v, 0xB1, 0xf, 0xf, true); v += __builtin_amdgcn_update_dpp(0, v, 0x4E, 0xf, 0xf, true); v += __builtin_amdgcn_update_dpp(0, v, 0x141, 0xf, 0xf, true);
    return v; }
DI unsigned oct_or(unsigned v) {
    v |= (unsigned)__builtin_amdgcn_update_dpp(0, (int)v, 0xB1, 0xf, 0xf, true); v |= (unsigned)__builtin_amdgcn_update_dpp(0, (int)v, 0x4E, 0xf, 0xf, true); v |= (unsigned)__builtin_amdgcn_update_dpp(0, (int)v, 0x141, 0xf, 0xf, true);
    return v; }
DI float half_sum(float v) { return v + __shfl_xor(v, 32); }
DI float half_max(float v) { return fmaxf(v, __shfl_xor(v, 32)); }
DI float bflo(unsigned w) { return __builtin_bit_cast(float, w << 16); }
DI float bfhi(unsigned w) { return __builtin_bit_cast(float, w & 0xffff0000u); }
DI float fast_exp2(float x) { return __builtin_amdgcn_exp2f(x); }
DI float sigmoidf_(float x) { return 1.f / (1.f + __expf(-x)); }
DI float siluf_(float x) { return x / (1.f + __expf(-x)); }
DI int crow(int reg, int h) { return (reg & 3) + 8 * (reg >> 2) + 4 * h; }
#define MFMA32(a, b, c) __builtin_amdgcn_mfma_f32_32x32x16_bf16((a), (b), (c), 0, 0, 0)

constexpr int BATCH = 2, SEQ = 8192, DM = 2048, MTOK = BATCH * SEQ;
constexpr int N_EVEN = 6696, N_ODD = 6672;
constexpr float EPS = 1e-6f;
constexpr float LOG2E = 1.4426950408889634f;

namespace pg8 {
constexpr int BM = 256, BK = 64, HALF = 128, HTB = HALF * BK * 2, STAGE_BYTES = 8 * HTB, NXCD = 8, WGM = 8;
__host__ __device__ __forceinline__ int lds_byte(int r, int c) { const int st = (r >> 4) * 2 + (c >> 5), rr = r & 15, cc = c & 31, ob = rr * 64 + cc * 2; return st * 1024 + (ob ^ (((ob >> 9) & 1) << 5)); }
__host__ __device__ __forceinline__ void stage_rc(int b, int& R, int& C) { const int st = b / 1024, sb = b % 1024, swz = sb ^ (((sb >> 9) & 1) << 5); R = (st >> 1) * 16 + swz / 64; C = (st & 1) * 32 + (swz % 64) / 2; }
__host__ __device__ __forceinline__ int perm32(int rho) { const int n = rho >> 4, i = rho & 15; return 8 * (i >> 2) + 4 * n + (i & 3); }

struct Unit { int pm, pn, job, ks; };
struct Gemm { const bf16_t* A[2]; const bf16_t* Bt[2]; int nM[2], nN[2], nK[2]; int lda, ldb, Klen; int chain; };

struct MultiOrder {
    int n0, n1, G, c; int nM0, nN0, nK0, nM1, nN1, nK1, chain;
    __device__ __forceinline__ void init(const Gemm& g, int G_, int c_) { nM0 = g.nM[0]; nN0 = g.nN[0]; nK0 = g.nK[0]; nM1 = g.nM[1]; nN1 = g.nN[1]; nK1 = g.nK[1]; n0 = nM0 * nN0 * nK0; n1 = nM1 * nN1 * nK1; G = G_; c = c_; chain = g.chain; }
    __device__ __forceinline__ static void tile(int wgid, int nM, int nN, int nK, Unit& u) {
        if (nK > 1) { u.ks = wgid % nK; wgid /= nK; u.pn = wgid % nN; u.pm = wgid / nN; return; }
        u.ks = 0; const int nwg = nM * nN;
        { const int q = nwg / NXCD, r = nwg % NXCD, xcd = wgid % NXCD, off = wgid / NXCD; wgid = (xcd < r ? xcd * (q + 1) : r * (q + 1) + (xcd - r) * q) + off; }
        const int nig = WGM * nN, gid = wgid / nig, fm = gid * WGM, gsz = (nM - fm) < WGM ? (nM - fm) : WGM;
        u.pm = fm + ((wgid % nig) % gsz); u.pn = (wgid % nig) / gsz;
    }
    __device__ __forceinline__ bool next(int i, Unit& u) const {
        if (chain) { const long T = (long)(i / nK0) * G + c; if (T >= nM0 * nN0) return false; u.job = 0; tile((int)T, nM0, nN0, 1, u); u.ks = i % nK0; return true; }
        const long L = (long)i * G + c; if (L >= n0 + n1) return false;
        if (L < n0) { u.job = 0; tile((int)L, nM0, nN0, nK0, u); } else { u.job = 1; tile((int)L - n0, nM1, nN1, nK1, u); }
        return true;
    }
};

template <class Epi>
__device__ __forceinline__ void gemm_phase(LAS unsigned char* lds, const Gemm& g, const MultiOrder& S, const Epi& E) {
    static_assert(Epi::PERM, "this copy keeps only the PERM = true staging");
    const int tid = threadIdx.x, wid = __builtin_amdgcn_readfirstlane(tid >> 6), lane = tid & 63, wr = wid >> 2, wc = wid & 3, fr = lane & 15, fq = lane >> 4;
    const int nt = g.Klen / BK;
    unsigned voffA[2], voffB[2];
#pragma unroll
    for (int i = 0; i < 2; ++i) { int R, C; stage_rc(tid * 16 + i * 8192, R, C); const int Rb = (R & ~31) + perm32(R & 31);
        voffA[i] = (unsigned)(R * g.lda + C) * 2u; voffB[i] = (unsigned)(Rb * g.ldb + C) * 2u; }
    const size_t kstep = (size_t)(BK * 2);
    const size_t hstepA = (size_t)HALF * g.lda * 2, hstepB = (size_t)HALF * g.ldb * 2;
    const unsigned ldsw = (unsigned)wid * 1024u;
    const int aoff = lds_byte(wr * 64 + fr, fq * 8), boff = lds_byte(wc * 32 + fr, fq * 8);
#define PG8_SA(b, h) (((b) * 2 + (h)) * HTB)
#define PG8_SB(b, h) ((4 + (b) * 2 + (h)) * HTB)
#define PG8_STAGE(bufoff, gbase, voff) do { _Pragma("unroll") for (int _i = 0; _i < 2; ++_i) \
        __builtin_amdgcn_global_load_lds((const unsigned*)((const char*)(gbase) + (voff)[_i]), (LAS unsigned*)(lds + (bufoff) + ldsw + _i * 8192), 16, 0, 0); } while (0)
#define PG8_LDA(dst, b, h) do { _Pragma("unroll") for (int m = 0; m < 4; ++m) _Pragma("unroll") for (int k = 0; k < 2; ++k) dst[m][k] = *(const LAS bf16x8*)(lds + PG8_SA(b, h) + aoff + m * 2048 + k * 1024); } while (0)
#define PG8_LDB(dst, b, h) do { _Pragma("unroll") for (int n = 0; n < 2; ++n) _Pragma("unroll") for (int k = 0; k < 2; ++k) dst[n][k] = *(const LAS bf16x8*)(lds + PG8_SB(b, h) + boff + n * 2048 + k * 1024); } while (0)
#define PG8_MMA(ai, bj, At, Bt) do { __builtin_amdgcn_s_setprio(1); _Pragma("unroll") for (int m = 0; m < 4; ++m) _Pragma("unroll") for (int n = 0; n < 2; ++n) _Pragma("unroll") for (int k = 0; k < 2; ++k) \
        acc[ai][bj][m][n] = __builtin_amdgcn_mfma_f32_16x16x32_bf16(Bt[n][k], At[m][k], acc[ai][bj][m][n], 0, 0, 0); __builtin_amdgcn_s_setprio(0); } while (0)
#define PG8_WAIT_V(n) asm volatile("s_waitcnt vmcnt(" #n ")" ::: "memory")
#define PG8_WAIT_L(n) asm volatile("s_waitcnt lgkmcnt(" #n ")" ::: "memory")
#define PG8_BAR __builtin_amdgcn_s_barrier()
#define PG8_SCHED __builtin_amdgcn_sched_barrier(0)
#define PG8_UA(u) ((const char*)((u).job ? g.A[1] : g.A[0]) + ((size_t)(u).pm * BM * g.lda + (size_t)(u).ks * g.Klen) * 2)
#define PG8_UB(u) ((const char*)((u).job ? g.Bt[1] : g.Bt[0]) + ((size_t)(u).pn * BM * g.ldb + (size_t)(u).ks * g.Klen) * 2)
    Unit cur, nxt; int ui = 0;
    if (!S.next(0, cur)) return;
    f32x4 acc[2][2][4][2];
#pragma unroll
    for (int a = 0; a < 2; ++a)
#pragma unroll
        for (int b = 0; b < 2; ++b)
#pragma unroll
            for (int m = 0; m < 4; ++m)
#pragma unroll
                for (int n = 0; n < 2; ++n) acc[a][b][m][n] = (f32x4){0.f, 0.f, 0.f, 0.f};
    bf16x8 At[4][2], B0[2][2], B1[2][2];
    const char* cA = PG8_UA(cur); const char* cB = PG8_UB(cur);
    PG8_STAGE(PG8_SB(0, 0), cB, voffB); PG8_STAGE(PG8_SB(0, 1), cB + hstepB, voffB); PG8_STAGE(PG8_SA(0, 0), cA, voffA); PG8_STAGE(PG8_SA(0, 1), cA + hstepA, voffA);
    if (wr == 1) PG8_BAR;
    PG8_WAIT_V(2); PG8_BAR;
    PG8_STAGE(PG8_SB(1, 0), cB + kstep, voffB); PG8_STAGE(PG8_SA(1, 0), cA + kstep, voffA); PG8_STAGE(PG8_SB(1, 1), cB + hstepB + kstep, voffB);
    PG8_WAIT_V(6); PG8_BAR;
    for (;;) {
        const bool has_next = S.next(ui + 1, nxt);
        const char* nA = has_next ? PG8_UA(nxt) : cA; const char* nB = has_next ? PG8_UB(nxt) : cB;
        for (int t = 0; t < nt; t += 2) {
            const bool last = (t == nt - 2);
            const char* a1 = cA + (size_t)(t + 1) * kstep;
            const char* a2 = last ? nA : cA + (size_t)(t + 2) * kstep; const char* b2 = last ? nB : cB + (size_t)(t + 2) * kstep;
            const char* a3 = a2 + kstep; const char* b3 = b2 + kstep;
            PG8_LDB(B0, 0, 0); PG8_LDB(B1, 0, 1); PG8_SCHED; PG8_LDA(At, 0, 0); PG8_STAGE(PG8_SA(1, 1), a1 + hstepA, voffA);
            PG8_WAIT_V(8); PG8_WAIT_L(0); PG8_BAR; PG8_MMA(0, 0, At, B0); PG8_MMA(0, 1, At, B1); PG8_BAR; PG8_SCHED;
            PG8_LDA(At, 0, 1); PG8_STAGE(PG8_SB(0, 0), b2, voffB); PG8_STAGE(PG8_SB(0, 1), b2 + hstepB, voffB); PG8_STAGE(PG8_SA(0, 0), a2, voffA);
            PG8_WAIT_V(8); PG8_WAIT_L(0); PG8_BAR; PG8_MMA(1, 0, At, B0); PG8_MMA(1, 1, At, B1); PG8_BAR; PG8_SCHED;
            PG8_LDB(B0, 1, 0); PG8_LDB(B1, 1, 1); PG8_SCHED; PG8_LDA(At, 1, 0); PG8_STAGE(PG8_SA(0, 1), a2 + hstepA, voffA);
            PG8_WAIT_V(8); PG8_WAIT_L(0); PG8_BAR; PG8_MMA(0, 0, At, B0); PG8_MMA(0, 1, At, B1); PG8_BAR; PG8_SCHED;
            PG8_LDA(At, 1, 1); PG8_STAGE(PG8_SB(1, 0), b3, voffB); PG8_STAGE(PG8_SB(1, 1), b3 + hstepB, voffB); PG8_STAGE(PG8_SA(1, 0), a3, voffA);
            PG8_WAIT_V(8); PG8_WAIT_L(0); PG8_BAR; PG8_MMA(1, 0, At, B0); PG8_MMA(1, 1, At, B1); PG8_BAR; PG8_SCHED;
        }
        if (wr == 0) PG8_BAR;
        const bool keep = E(acc, cur, wr, wc, fr, fq);
        if (!has_next) break;
        if (!keep) {
#pragma unroll
            for (int a = 0; a < 2; ++a)
#pragma unroll
                for (int b = 0; b < 2; ++b)
#pragma unroll
                    for (int m = 0; m < 4; ++m)
#pragma unroll
                        for (int n = 0; n < 2; ++n) acc[a][b][m][n] = (f32x4){0.f, 0.f, 0.f, 0.f};
        }
        cur = nxt; cA = nA; cB = nB; ++ui;
        if (wr == 1) PG8_BAR;
    }
    PG8_WAIT_V(0);
    PG8_BAR;
#undef PG8_SA
#undef PG8_SB
#undef PG8_STAGE
#undef PG8_LDA
#undef PG8_LDB
#undef PG8_MMA
#undef PG8_WAIT_V
#undef PG8_WAIT_L
#undef PG8_BAR
#undef PG8_SCHED
#undef PG8_UA
#undef PG8_UB
}
}
#define XB_TMO      128
#define XB_XCNT(j)  (256  + 64 * (j))
#define XB_XSUB(j)  (1280 + 64 * (j))
#define XB_XGEN(j)  (2304 + 64 * (j))
#define XB_TOP      3328
#define XB_TOPGEN   3392
#define XCD_BAR_WORDS 3456
#define XB_SPIN_CAP (1u << 24)
DI unsigned xb_ld(unsigned* p)              { return __hip_atomic_load(p, __ATOMIC_RELAXED, __HIP_MEMORY_SCOPE_AGENT); }
DI unsigned xb_add(unsigned* p, unsigned v) { return __hip_atomic_fetch_add(p, v, __ATOMIC_RELAXED, __HIP_MEMORY_SCOPE_AGENT); }
DI unsigned xb_xcc_id() { return (unsigned)__builtin_amdgcn_s_getreg((3 << 11) | 20) & 0xFu; }
#define XB_SPIN(cond, bar) do { unsigned _sp = 0; while (cond) { __builtin_amdgcn_s_sleep(1); \
    if ((++_sp & 255u) == 0u) { if (xb_ld(&(bar)[XB_TMO])) break; if (_sp > XB_SPIN_CAP) { atomicAdd(&(bar)[XB_TMO], 1u); break; } } } } while (0)
struct XcdBarrier { unsigned* bar; unsigned x; volatile LAS unsigned* st; };
DI XcdBarrier xcd_barrier_post(unsigned* bar, volatile LAS unsigned* st) {
    XcdBarrier b; b.bar = bar; b.x = xb_xcc_id(); b.st = st;
    if (threadIdx.x == 0) (void)xb_add(&bar[XB_XCNT(b.x)], 1u);
    return b;
}
DI void xcd_barrier_complete(unsigned* bar, unsigned x, unsigned& nloc, unsigned& nx) {
    const unsigned G = gridDim.x * gridDim.y * gridDim.z;
    unsigned sum, cnt, mine, sp = 0u;
    for (;;) {
        sum = 0u; cnt = 0u; mine = 0u;
#pragma unroll
        for (unsigned j = 0; j < 16; ++j) { const unsigned c = xb_ld(&bar[XB_XCNT(j)]); sum += c; cnt += (c > 0u) ? 1u : 0u; mine = (j == x) ? c : mine; }
        if (sum == G) break;
        __builtin_amdgcn_s_sleep(1);
        if ((++sp & 255u) == 0u) { if (xb_ld(&bar[XB_TMO])) break; if (sp > XB_SPIN_CAP) { atomicAdd(&bar[XB_TMO], 1u); break; } }
    }
    nloc = mine > 0u ? mine : 1u; nx = cnt > 0u ? cnt : 1u;
}
DI void xcd_barrier(const XcdBarrier& b) {
    asm volatile("s_waitcnt vmcnt(0)" ::: "memory");
    __syncthreads();
    if (threadIdx.x == 0) {
        unsigned* bar = b.bar;
        __builtin_amdgcn_s_waitcnt(0);
        unsigned nloc = b.st[0], nx = b.st[1];
        if (nloc == 0u) { xcd_barrier_complete(bar, b.x, nloc, nx); b.st[0] = nloc; b.st[1] = nx; }
        const unsigned old = xb_add(&bar[XB_XSUB(b.x)], 1u);
        const unsigned gen = old / nloc;
        if (old + 1u == (gen + 1u) * nloc) {
            __builtin_amdgcn_fence(__ATOMIC_RELEASE, "agent");
            asm volatile("s_waitcnt vmcnt(0)" ::: "memory");
            const unsigned og = xb_add(&bar[XB_TOP], 1u);
            const unsigned tg = og / nx;
            if (og + 1u == (tg + 1u) * nx) xb_add(&bar[XB_TOPGEN], 1u);
            else XB_SPIN(xb_ld(&bar[XB_TOPGEN]) == tg, bar);
            __builtin_amdgcn_fence(__ATOMIC_ACQUIRE, "agent");
            xb_add(&bar[XB_XGEN(b.x)], 1u);
            asm volatile("s_waitcnt vmcnt(0)" ::: "memory");
        } else {
            XB_SPIN(xb_ld(&bar[XB_XGEN(b.x)]) == gen, bar);
            __builtin_amdgcn_fence(__ATOMIC_ACQUIRE, "agent");
            asm volatile("s_waitcnt vmcnt(0)" ::: "memory");
        }
    }
    __syncthreads();
}

constexpr size_t MiB = 1u << 20;
constexpr size_t WS_CTL = 0, CTL_ZERO_BYTES = 64 * 1024;
constexpr int NN0 = 5376, NT0 = 1536, NN1 = 4864, NT1 = 2048;
constexpr size_t WS_WN0 = 1 * MiB;
constexpr size_t WS_WT0 = WS_WN0 + (size_t)NN0 * DM * 2;
constexpr size_t WS_WO0 = WS_WT0 + (size_t)NT0 * DM * 2;
constexpr size_t WS_W1K = WS_WO0 + (size_t)DM * DM * 2;
constexpr size_t WS_W1V = WS_W1K + (size_t)256 * 4096 * 2;
constexpr size_t WS_WN1 = WS_W1V + (size_t)256 * 4096 * 2;
constexpr size_t WS_WT1 = WS_WN1 + (size_t)NN1 * DM * 2;
constexpr size_t WS_WO1 = WS_WT1 + (size_t)NT1 * DM * 2;
constexpr size_t WS_WEND = WS_WO1 + (size_t)DM * DM * 2;
constexpr size_t WS_BL   = 75 * MiB;
static_assert(WS_WEND <= WS_BL && WS_BL + 2 * MiB <= 78 * MiB, "weights");
constexpr size_t WS_SMALL = 78 * MiB;
constexpr size_t WS_MOD   = WS_SMALL;
constexpr size_t WS_ROPE  = WS_SMALL + 1 * MiB;
constexpr size_t WS_LB    = WS_SMALL + 5 * MiB;
constexpr size_t WS_B1P   = WS_LB + 4096;
constexpr size_t WS_KC    = WS_SMALL + 6 * MiB;
constexpr size_t WS_VCT   = WS_KC + 512 * 1024;
constexpr size_t WS_SSQ   = WS_SMALL + 7 * MiB;
constexpr size_t WS_RTAB  = WS_SMALL + 7 * MiB + 512 * 1024 * 2;
constexpr size_t WS_LOGD  = WS_SMALL + 8 * MiB;
constexpr size_t WS_HY    = 88 * MiB;
constexpr size_t WS_ACT   = 152 * MiB;
constexpr size_t WS_CONCAT= 368 * MiB;
constexpr size_t WS_OW    = 432 * MiB;
constexpr size_t WS_U0    = 464 * MiB;
constexpr size_t WS_OC    = 480 * MiB;
constexpr size_t WS_END   = 512 * MiB;
constexpr size_t A0_GQ = 0, A0_GK = 16 * MiB, A0_GZ = 32 * MiB, A0_GVT = 64 * MiB, A0_NQ = 96 * MiB, A0_NZ = 128 * MiB;
constexpr size_t A0_NKC = 160 * MiB, A0_NVC = 169 * MiB, A0_NKS = 178 * MiB, A0_NKW = 186 * MiB, A0_NVST = 194 * MiB, A0_NVWT = 202 * MiB;
constexpr size_t A0_GLR = 210 * MiB, A0_NGATE = 211 * MiB;
constexpr size_t ACT_BYTES = 216 * MiB;
static_assert(A0_NVWT + 8 * MiB <= A0_GLR && A0_GLR + 1 * MiB <= A0_NGATE && A0_NGATE + 2 * MiB <= ACT_BYTES, "layer-0 act map");
constexpr size_t A1_HQ = 0, A1_HF = 32 * MiB, A1_HZ = 64 * MiB, A1_SZ = 96 * MiB, A1_BC = 128 * MiB, A1_HIT = 144 * MiB, A1_XST = 176 * MiB, A1_SDT = 208 * MiB, A1_BS = 209 * MiB, A1_DTV = 210 * MiB, A1_WJ = 211 * MiB;
static_assert(A1_WJ + 1 * MiB <= ACT_BYTES && A1_XST + 32 * MiB <= A1_SDT && WS_ACT + ACT_BYTES <= WS_CONCAT && WS_CONCAT + 64 * MiB <= WS_OW && WS_OW + 32 * MiB <= WS_U0 && WS_U0 + 16 * MiB <= WS_OC && WS_OC + 32 * MiB <= WS_END, "ws map");
constexpr int CW_BAR = 4096;

constexpr int RING_BYTES = 147456;
constexpr int LDSCTL_OFF = RING_BYTES, MISC_OFF = LDSCTL_OFF + 320;
constexpr int LDS_BYTES = RING_BYTES + 1024;
constexpr int NWAVES = 8, NTHR = 512;

struct Args { const float* in[27]; float* out; unsigned char* ws; int ph_lo, ph_hi; };
typedef const __attribute__((address_space(4))) Args CArgs;

#ifndef PROF_BID
#define PROF_BID -1
#endif
#ifndef PROF_SCALE
#define PROF_SCALE 1.0f
#endif
#if PROF_BID >= 0
DI void prof_lap(LAS unsigned char* lds, unsigned char* ws, int k) {
    if (blockIdx.x == PROF_BID && threadIdx.x == 0) {
        const unsigned long long now = __builtin_amdgcn_s_memrealtime();
        LAS unsigned long long* last = (LAS unsigned long long*)(lds + RING_BYTES + 64);
        unsigned long long* ts = (unsigned long long*)(ws + 32768);
        ts[k] += now - *last; *last = now;
    }
}
#ifdef PROF_SECTIONS
#define PROF(k) prof_lap(F.lds, a.ws, (k))
#else
#define PROF(k) do {} while (0)
#endif
#else
#define PROF(k) do {} while (0)
#endif
struct Frame {
    LAS unsigned char* lds;
    int tid, lane, wave, G, bid;
};
DI float wave_sum(float v) {
#pragma unroll
    for (int o = 1; o < 64; o <<= 1) v += __shfl_xor(v, o);
    return v;
}

DI int dperm(int p) { return (p >> 1) + 64 * (p & 1); }
DI int src_wn0(int n) {
    if (n < 1024) return n;
    if (n < 2048) return 2064 + (n - 1024);
    if (n < 3072) { const int r = n - 2048; return 3088 + (r & ~127) + dperm(r & 127); }
    if (n < 3328) { const int r = n - 3072; return 4112 + (r & ~127) + dperm(r & 127); }
    if (n < 3584) { const int r = n - 3328; return 4624 + (r & ~127) + dperm(r & 127); }
    if (n < 3840) { const int r = n - 3584; return 5136 + (r & ~127) + dperm(r & 127); }
    if (n < 4096) return 4368 + (n - 3840);
    if (n < 5120) return 5672 + (n - 4096);
    const int r = n - 5120; if (r < 16) return 2048 + r; if (r < 40) return 5648 + (r - 16); return -1;
}
DI int src_wt0(int n) { if (n < 1024) return 1024 + n; if (n < 1280) return 4880 + (n - 1024); return 5392 + (n - 1280); }
DI int src_wn1(int n) {
    if (n < 1024) return n;
    if (n < 2048) return n;
    if (n < 3072) return 3072 + (n - 2048);
    if (n < 4096) return 4096 + (n - 3072);
    if (n < 4608) return 6144 + (n - 4096);
    const int r = n - 4608; return r < 16 ? 6656 + r : -1;
}
DI int src_wt1(int n) { return n < 1024 ? 2048 + n : 5120 + (n - 1024); }
DI int inv_dperm(int d) { return d < 64 ? 2 * d : 2 * (d - 64) + 1; }
template <int MID> DI int tr_srccol(int n) {
    if constexpr (MID == 0) return src_wn0(n); else if constexpr (MID == 1) return src_wt0(n); else if constexpr (MID == 5) return src_wn1(n); else if constexpr (MID == 6) return src_wt1(n); else return n;
}
template <int MID> DI int tr_srcrow(int k) {
    if constexpr (MID == 3) return (k & ~127) + dperm(k & 127);
    else if constexpr (MID == 7) return k < 1024 ? 1024 + k : k - 1024;
    else return k;
}
template <int MID> DI void tr_item(const float* W, int ldw, bf16_t* WT, int Kd, int Nd, const float* kscale, LAS float* scr, int item, int lane) {
    const int nblk = Nd / 32, kb = item / nblk, nb = item % nblk, k0 = 64 * kb, n0 = 32 * nb;
    int c0 = tr_srccol<MID>(n0); const int c31 = tr_srccol<MID>(n0 + 31);
    bool perm = false; int db = 0, q0 = 0;
    if constexpr (MID == 0) { if (n0 >= 2048 && n0 < 3840) { perm = true; int sb;
            if (n0 < 3072) { db = 2048; sb = 3088; } else if (n0 < 3328) { db = 3072; sb = 4112; } else if (n0 < 3584) { db = 3328; sb = 4624; } else { db = 3584; sb = 5136; }
            q0 = n0 - db; c0 = sb + q0; } }
    if (perm || (c0 >= 0 && c31 - c0 == 31)) {
        const int kk0 = lane >> 3, g4 = (lane & 7) * 4;
        f32x4 v[8];
#pragma unroll
        for (int i = 0; i < 8; ++i) { const int kk = kk0 + 8 * i; v[i] = *(const f32x4*)(W + (size_t)tr_srcrow<MID>(k0 + kk) * ldw + c0 + g4); }
#pragma unroll
        for (int i = 0; i < 8; ++i) { const int kk = kk0 + 8 * i; f32x4 x = v[i];
            if constexpr (MID == 7) { if (k0 + kk < 1024) x = x * kscale[k0 + kk]; }
            scr[kk * 33 + g4] = x[0]; scr[kk * 33 + g4 + 1] = x[1]; scr[kk * 33 + g4 + 2] = x[2]; scr[kk * 33 + g4 + 3] = x[3]; }
    } else {
        const int sc = tr_srccol<MID>(n0 + (lane & 31));
#pragma unroll 8
        for (int i = 0; i < 32; ++i) { const int kk = 2 * i + (lane >> 5); const int sr = tr_srcrow<MID>(k0 + kk);
            float v = sc >= 0 ? W[(size_t)sr * ldw + sc] : 0.f;
            if constexpr (MID == 7) { if (k0 + kk < 1024) v *= kscale[k0 + kk]; }
            scr[kk * 33 + (lane & 31)] = v; }
    }
    asm volatile("s_waitcnt lgkmcnt(0)" ::: "memory");
    const int c = lane & 7;
#pragma unroll
    for (int j = 0; j < 4; ++j) { const int n = (lane >> 3) + 8 * j; const LAS float* s = scr + (8 * c) * 33 + n;
        u32x4 o; o.x = pk2(s[0 * 33], s[1 * 33]); o.y = pk2(s[2 * 33], s[3 * 33]); o.z = pk2(s[4 * 33], s[5 * 33]); o.w = pk2(s[6 * 33], s[7 * 33]);
        const int nrow = perm ? db + ((q0 + n) & ~127) + inv_dperm((q0 + n) & 127) : n0 + n;
        *(u32x4*)(WT + (size_t)nrow * Kd + k0 + 8 * c) = o; }
    asm volatile("s_waitcnt lgkmcnt(0)" ::: "memory");
}
DI void p0_weights(const Frame& F, CArgs& a, int part, int gw, int NGW) {
    unsigned char* ws = a.ws;
    LAS float* scr = (LAS float*)(F.lds + F.wave * 16384);
    constexpr int I0 = 32 * (NN0 / 32), I1 = 32 * (NT0 / 32), I2 = 32 * 64, I3 = 64 * 8, I4 = 64 * 8, I5 = 32 * (NN1 / 32), I6 = 32 * (NT1 / 32), I7 = 32 * 64;
    constexpr int NITEMS = I0 + I1 + I2 + I3 + I4 + I5 + I6 + I7;
    constexpr int NL0 = I0 + I1 + I2 + I3 + I4;
    const int it_lo = part == 0 ? 0 : part == 1 ? NL0 : NL0 + I5 + I6, it_hi = part == 0 ? NL0 : part == 1 ? NL0 + I5 + I6 : NITEMS;
    for (int it = it_lo + gw; it < it_hi; it += NGW) {
        int r = it;
        if (r < I0) { tr_item<0>(a.in[6], N_EVEN, (bf16_t*)(ws + WS_WN0), DM, NN0, nullptr, scr, r, F.lane); continue; } r -= I0;
        if (r < I1) { tr_item<1>(a.in[6], N_EVEN, (bf16_t*)(ws + WS_WT0), DM, NT0, nullptr, scr, r, F.lane); continue; } r -= I1;
        if (r < I2) { tr_item<2>(a.in[7], DM, (bf16_t*)(ws + WS_WO0), DM, DM, nullptr, scr, r, F.lane); continue; } r -= I2;
        if (r < I3) { tr_item<3>(a.in[12], 256, (bf16_t*)(ws + WS_W1K), 4096, 256, nullptr, scr, r, F.lane); continue; } r -= I3;
        if (r < I4) { tr_item<4>(a.in[15], 256, (bf16_t*)(ws + WS_W1V), 4096, 256, nullptr, scr, r, F.lane); continue; } r -= I4;
        if (r < I5) { tr_item<5>(a.in[17], N_ODD, (bf16_t*)(ws + WS_WN1), DM, NN1, nullptr, scr, r, F.lane); continue; } r -= I5;
        if (r < I6) { tr_item<6>(a.in[17], N_ODD, (bf16_t*)(ws + WS_WT1), DM, NT1, nullptr, scr, r, F.lane); continue; } r -= I6;
        tr_item<7>(a.in[18], DM, (bf16_t*)(ws + WS_WO1), DM, DM, a.in[26], scr, r, F.lane);
    }
}
DI void p0_prologue(const Frame& F, CArgs& a) {
    unsigned char* ws = a.ws;
    LAS float* scr = (LAS float*)(F.lds + F.wave * 16384);
    const int gw = F.bid * NWAVES + F.wave, NGW = F.G * NWAVES;
    PROF(80);
    __syncthreads();
    {
        LAS float* cact = (LAS float*)(F.lds);
        LAS float* red = (LAS float*)(F.lds + 16384);
        for (int e = F.tid; e < 2 * DM; e += NTHR) cact[e] = siluf_(a.in[1][e]);
        __syncthreads();
        for (int it = F.bid; it < 2 * 96; it += F.G) {
            const int l = it / 96, n0 = (it % 96) * 64, n = n0 + F.lane;
            const float* W = a.in[2] + (size_t)l * DM * 6144;
            float a0 = 0.f, a1 = 0.f;
            const int kb = F.wave * 256;
#pragma unroll 1
            for (int k = kb; k < kb + 256; k += 32) {
                float wv[32];
#pragma unroll
                for (int i = 0; i < 32; ++i) wv[i] = __builtin_nontemporal_load(W + (size_t)(k + i) * 6144 + n);
#pragma unroll
                for (int i = 0; i < 32; ++i) { a0 += cact[k + i] * wv[i]; a1 += cact[DM + k + i] * wv[i]; }
            }
            red[(F.wave * 2 + 0) * 64 + F.lane] = a0; red[(F.wave * 2 + 1) * 64 + F.lane] = a1;
            __syncthreads();
            if (F.tid < 128) { const int b = F.tid >> 6, ln = F.tid & 63; float s = 0.f;
#pragma unroll
                for (int w = 0; w < 8; ++w) s += red[(w * 2 + b) * 64 + ln];
                ((float*)(ws + WS_MOD))[(size_t)(l * 2 + b) * 6144 + n0 + ln] = s + a.in[3][l * 6144 + n0 + ln]; }
            __syncthreads();
        }
    }
    PROF(81);
    {
        const int gt = F.bid * NTHR + F.tid, NGT = F.G * NTHR;
        static_assert((256 * NTHR) % 64 == 0, "rope: a thread keeps its frequency index");
        double fr = 1.0; { const double r1 = 0.86596432336006535;
            const int i0 = gt & 63; for (int q = 0; q < i0; ++q) fr *= r1; }
        for (int e = gt; e < SEQ * 64; e += NGT) {
            const int pos = e >> 6;
            const float invf32 = (float)fr;
            const float angf = (float)pos * invf32;
            double x = (double)angf;
            const double TWO_PI = 6.283185307179586476925, INV_2PI = 0.15915494309189533577;
            double kq = __builtin_rint(x * INV_2PI); x -= kq * TWO_PI;
            const double HALF_PI = 1.5707963267948966192;
            double qd = __builtin_rint(x * 0.63661977236758134308); const double r = x - qd * HALF_PI; const int qi = ((int)qd) & 3;
            const double r2 = r * r;
            const double s = r * (1.0 + r2 * (-1.0 / 6 + r2 * (1.0 / 120 + r2 * (-1.0 / 5040 + r2 * (1.0 / 362880 + r2 * (-1.0 / 39916800 + r2 * (1.0 / 6227020800.0)))))));
            const double cc = 1.0 + r2 * (-0.5 + r2 * (1.0 / 24 + r2 * (-1.0 / 720 + r2 * (1.0 / 40320 + r2 * (-1.0 / 3628800 + r2 * (1.0 / 479001600.0 + r2 * (-1.0 / 87178291200.0)))))));
            double sn, cs;
            if (qi == 0) { sn = s; cs = cc; } else if (qi == 1) { sn = cc; cs = -s; } else if (qi == 2) { sn = -s; cs = -cc; } else { sn = -cc; cs = s; }
            ((f32x2*)(ws + WS_ROPE))[e] = (f32x2){(float)cs, (float)sn};
        }
    }
    PROF(82);
    if (F.bid == 0) { for (int d = F.tid; d < 1024; d += NTHR) { const float g0 = a.in[19][d], g1 = a.in[19][1024 + d]; ((float*)(ws + WS_LB))[d] = 1.f / (1.f + __expf(g0 - g1)); } }
    if (F.bid >= 1 && F.bid <= 128) {
        const int m = (F.bid - 1) >> 6, j = (F.bid - 1) & 63;
        const float* pe = a.in[m ? 14 : 11]; const float* w1 = a.in[m ? 15 : 12];
        LAS float* red = (LAS float*)(F.lds);
        const int cidx = F.tid & 255, kh = F.tid >> 8; float s0 = 0.f, s1 = 0.f;
        const int kb = 64 * j + 32 * kh;
#pragma unroll
        for (int k = 0; k < 32; k += 2) { s0 += pe[kb + k] * w1[(size_t)(kb + k) * 256 + cidx]; s1 += pe[kb + k + 1] * w1[(size_t)(kb + k + 1) * 256 + cidx]; }
        __syncthreads(); red[F.tid] = s0 + s1; __syncthreads();
        if (F.tid < 256) ((float*)(ws + WS_B1P))[(size_t)(m * 64 + j) * 256 + F.tid] = red[F.tid] + red[256 + F.tid];
        __syncthreads();
    }
}

DI void load_row_f32(const float* row, int lane, f32x4 (&v)[8]) {
#pragma unroll
    for (int j = 0; j < 8; ++j) v[j] = *(const f32x4*)(row + 4 * lane + 256 * j);
}
DI float sumsq8(const f32x4 (&v)[8]) { float s = 0.f;
#pragma unroll
    for (int j = 0; j < 8; ++j) s += (v[j].x * v[j].x + v[j].y * v[j].y) + (v[j].z * v[j].z + v[j].w * v[j].w);
    return wave_sum(s); }
DI void modulate_store(const f32x4 (&v)[8], float rs, const float* w, const float* mod  , bf16_t* hrow, int lane) {
#pragma unroll
    for (int j = 0; j < 8; ++j) { const int c = 4 * lane + 256 * j;
        const f32x4 ww = *(const f32x4*)(w + c), sh = *(const f32x4*)(mod + c), sc = *(const f32x4*)(mod + 2048 + c);
        const f32x4 o = v[j] * rs * ww * (sc + 1.0f) + sh;
        u32x2 p; p.x = pk2(o.x, o.y); p.y = pk2(o.z, o.w); *(u32x2*)(hrow + c) = p; }
}
DI void stage_table(LAS float* dst, const float* src, int tid) {
    for (int e = tid; e < 512; e += NTHR) *(LAS f32x4*)(dst + 4 * e) = *(const f32x4*)(src + 4 * e);
}
DI void modulate_store_lds(const f32x4 (&v)[8], float rs, const LAS float* w, const LAS float* sh, const LAS float* sc, bf16_t* hrow, int lane) {
#pragma unroll
    for (int j = 0; j < 8; ++j) { const int c = 4 * lane + 256 * j;
        const f32x4 ww = *(const LAS f32x4*)(w + c), s0 = *(const LAS f32x4*)(sh + c), s1 = *(const LAS f32x4*)(sc + c);
        const f32x4 o = v[j] * rs * ww * (s1 + 1.0f) + s0;
        u32x2 p; p.x = pk2(o.x, o.y); p.y = pk2(o.z, o.w); *(u32x2*)(hrow + c) = p; }
}
DI void p1_prenorm0(const Frame& F, CArgs& a) {
    const int gw = F.bid * NWAVES + F.wave, NGW = F.G * NWAVES;
    bf16_t* H = (bf16_t*)(a.ws + WS_HY);
    LAS float* TB = (LAS float*)F.lds;
    const float* MOD = (const float*)(a.ws + WS_MOD);
    __syncthreads();
    stage_table(TB, a.in[4], F.tid);
    stage_table(TB + 2048, MOD, F.tid); stage_table(TB + 4096, MOD + 6144, F.tid);
    stage_table(TB + 6144, MOD + 2048, F.tid); stage_table(TB + 8192, MOD + 6144 + 2048, F.tid);
    __syncthreads();
    f32x4 xn[8]; int m = gw;
    if (m < MTOK) load_row_f32(a.in[0] + (size_t)m * DM, F.lane, xn);
    for (; m < MTOK; m += NGW) {
        f32x4 v[8];
#pragma unroll
        for (int j = 0; j < 8; ++j) v[j] = xn[j];
        if (m + NGW < MTOK) load_row_f32(a.in[0] + (size_t)(m + NGW) * DM, F.lane, xn);
        const float rs = 1.0f / sqrtf(sumsq8(v) * (1.0f / DM) + EPS);
        const int bsel = m >> 13;
        modulate_store_lds(v, rs, TB, TB + 2048 + bsel * 2048, TB + 6144 + bsel * 2048, H + (size_t)m * DM, F.lane);
    }
    __syncthreads();
}
template <int LAYER> DI void p_residual(const Frame& F, CArgs& a) {
    const int gw = F.bid * NWAVES + F.wave, NGW = F.G * NWAVES;
    bf16_t* HY = (bf16_t*)(a.ws + WS_HY);
    const float* xin = LAYER == 0 ? a.in[0] : a.out;
    LAS float* TB = (LAS float*)F.lds;
    const float* MOD = (const float*)(a.ws + WS_MOD);
    __syncthreads();
    stage_table(TB, a.in[5] + LAYER * DM, F.tid);
    stage_table(TB + 2048, MOD + (size_t)(LAYER * 2 + 0) * 6144 + 4096, F.tid); stage_table(TB + 4096, MOD + (size_t)(LAYER * 2 + 1) * 6144 + 4096, F.tid);
    if constexpr (LAYER == 0) {
        stage_table(TB + 6144, a.in[4] + DM, F.tid);
        stage_table(TB + 8192, MOD + (size_t)2 * 6144, F.tid); stage_table(TB + 10240, MOD + (size_t)3 * 6144, F.tid);
        stage_table(TB + 12288, MOD + (size_t)2 * 6144 + 2048, F.tid); stage_table(TB + 14336, MOD + (size_t)3 * 6144 + 2048, F.tid);
    }
    __syncthreads();
    u32x2 yn[8]; f32x4 xn[8]; int m = gw;
    if (m < MTOK) {
#pragma unroll
        for (int j = 0; j < 8; ++j) yn[j] = *(const u32x2*)(HY + (size_t)m * DM + 4 * F.lane + 256 * j);
        load_row_f32(xin + (size_t)m * DM, F.lane, xn);
    }
    for (; m < MTOK; m += NGW) {
        f32x4 y[8], x[8];
#pragma unroll
        for (int j = 0; j < 8; ++j) { const u32x2 p = yn[j]; y[j] = (f32x4){bflo(p.x), bfhi(p.x), bflo(p.y), bfhi(p.y)}; x[j] = xn[j]; }
        if (m + NGW < MTOK) {
#pragma unroll
            for (int j = 0; j < 8; ++j) yn[j] = *(const u32x2*)(HY + (size_t)(m + NGW) * DM + 4 * F.lane + 256 * j);
            load_row_f32(xin + (size_t)(m + NGW) * DM, F.lane, xn);
        }
        const float rsy = 1.0f / sqrtf(sumsq8(y) * (1.0f / DM) + EPS);
        const int bsel = m >> 13;
#pragma unroll
        for (int j = 0; j < 8; ++j) { const int c = 4 * F.lane + 256 * j;
            const f32x4 pw = *(const LAS f32x4*)(TB + c), gt = *(const LAS f32x4*)(TB + 2048 + bsel * 2048 + c);
            x[j] = x[j] + gt * (y[j] * rsy * pw);
            *(f32x4*)(a.out + (size_t)m * DM + c) = x[j]; }
        if constexpr (LAYER == 0) {
            const float rs = 1.0f / sqrtf(sumsq8(x) * (1.0f / DM) + EPS);
            modulate_store_lds(x, rs, TB + 6144, TB + 8192 + bsel * 2048, TB + 12288 + bsel * 2048, HY + (size_t)m * DM, F.lane);
        }
    }
    __syncthreads();
}
constexpr float QSCALE_GLA = 0.08838834764831845f;
constexpr float QSCALE_NSA = 0.12751743082459868f;
template <int LAYER> struct EpiProj {
    static constexpr bool PERM = true;
    unsigned char* ws;
    DI bool operator()(f32x4 (&acc)[2][2][4][2], const pg8::Unit& u, int wr, int wc, int fr, int fq) const {
        unsigned char* act = ws + WS_ACT;
        int mode = 0, ldc = 1024, coff = 0; size_t boff = 0; float sc = 1.f;
        const int pn = u.pn, pm = u.pm;
        if constexpr (LAYER == 0) {
            if (u.job == 0) {
                if (pn < 2)       { boff = A0_GQ; ldc = 512; coff = pn * 256; sc = QSCALE_GLA; }
                else if (pn < 4)  { boff = A0_GK; ldc = 512; coff = (pn - 2) * 256; }
                else if (pn < 8)  { boff = A0_GZ; coff = (pn - 4) * 256; }
                else if (pn < 12) { boff = A0_NQ; coff = (pn - 8) * 256; mode = 1; sc = QSCALE_NSA; }
                else if (pn == 12) { boff = A0_NKC; mode = 2; }
                else if (pn == 13) { boff = A0_NKS; mode = 2; }
                else if (pn == 14) { boff = A0_NKW; mode = 2; }
                else if (pn == 15) { boff = A0_NVC; mode = 3; }
                else if (pn < 20) { boff = A0_NZ; coff = (pn - 16) * 256; }
                else mode = 4;
            } else {
                if (pm < 4) { boff = A0_GVT; ldc = MTOK; coff = pn * 256; }
                else { boff = pm == 4 ? A0_NVST : A0_NVWT; mode = 6; }
            }
        } else {
            if (u.job == 0) {
                if (pn < 4)       { boff = A1_HQ; coff = pn * 256; }
                else if (pn < 8)  { boff = A1_HF; coff = (pn - 4) * 256; }
                else if (pn < 12) { boff = A1_HZ; coff = (pn - 8) * 256; }
                else if (pn < 16) { boff = A1_SZ; coff = (pn - 12) * 256; }
                else if (pn < 18) { boff = A1_BC; ldc = 512; coff = (pn - 16) * 256; }
                else mode = 4;
            } else {
                if (pm < 4) { boff = A1_HIT; ldc = MTOK; coff = pn * 256; }
                else { boff = A1_XST - (size_t)1024 * MTOK * 2; ldc = MTOK; coff = pn * 256; }
            }
        }
        bf16_t* base = (bf16_t*)(act + boff);
        const f32x2* rope = (const f32x2*)(ws + WS_ROPE);
#pragma unroll
        for (int ai = 0; ai < 2; ++ai)
#pragma unroll
            for (int m = 0; m < 4; ++m) {
                const int row = pm * 256 + ai * 128 + wr * 64 + m * 16 + fr;
#pragma unroll
                for (int bj = 0; bj < 2; ++bj) {
                    const int c8 = bj * 128 + wc * 32 + 8 * fq;
                    f32x4 v0 = acc[ai][bj][m][0], v1 = acc[ai][bj][m][1];
                    if (mode == 4) {
                        if constexpr (LAYER == 0) {
                            if (c8 < 16) { float* d = (float*)(act + A0_GLR) + (size_t)row * 16 + c8; *(f32x4*)d = v0; *(f32x4*)(d + 4) = v1; }
                            else if (c8 < 40) { float* d = (float*)(act + A0_NGATE) + (size_t)row * 24 + (c8 - 16);
                                f32x4 g0, g1;
#pragma unroll
                                for (int e = 0; e < 4; ++e) { g0[e] = sigmoidf_(v0[e]); g1[e] = sigmoidf_(v1[e]); }
                                *(f32x4*)d = g0; *(f32x4*)(d + 4) = g1; }
                        } else {
                            if (c8 < 16) { float* d = (float*)(act + A1_SDT) + (size_t)row * 16 + c8; *(f32x4*)d = v0; *(f32x4*)(d + 4) = v1; }
                        }
                        continue;
                    }
                    if (mode == 1 || mode == 2) {
                        const int i0 = (c8 & 127) >> 1;
                        const f32x4* cs = (const f32x4*)(rope + (size_t)(row & (SEQ - 1)) * 64 + i0);
                        const f32x4 c01 = cs[0], c23 = cs[1];
                        f32x4 r0, r1;
                        r0[0] = v0[0] * c01[0] - v0[1] * c01[1]; r0[1] = v0[0] * c01[1] + v0[1] * c01[0];
                        r0[2] = v0[2] * c01[2] - v0[3] * c01[3]; r0[3] = v0[2] * c01[3] + v0[3] * c01[2];
                        r1[0] = v1[0] * c23[0] - v1[1] * c23[1]; r1[1] = v1[0] * c23[1] + v1[1] * c23[0];
                        r1[2] = v1[2] * c23[2] - v1[3] * c23[3]; r1[3] = v1[2] * c23[3] + v1[3] * c23[2];
                        v0 = r0; v1 = r1;
                    }
                    v0 = v0 * sc; v1 = v1 * sc;
                    u32x4 w; w.x = pk2(v0[0], v0[1]); w.y = pk2(v0[2], v0[3]); w.z = pk2(v1[0], v1[1]); w.w = pk2(v1[2], v1[3]);
                    bf16_t* dst;
                    if (mode == 2 || mode == 3) dst = base + ((size_t)(((row >> 13) * 2 + (c8 >> 7)) * SEQ + (row & (SEQ - 1)))) * 128 + (c8 & 127);
                    else if (mode == 6) { const int fl = row & 255, tok = pn * 256 + c8; dst = base + ((size_t)(((tok >> 13) * 2 + (fl >> 7)) * 128 + (fl & 127))) * SEQ + (tok & (SEQ - 1)); }
                    else dst = base + (size_t)row * ldc + coff + c8;
                    *(u32x4*)dst = w;
                }
            }
        return false;
    }
};
struct EpiBf16 {
    static constexpr bool PERM = true;
    bf16_t* O; int ldc;
    DI bool operator()(f32x4 (&acc)[2][2][4][2], const pg8::Unit& u, int wr, int wc, int fr, int fq) const {
#pragma unroll
        for (int ai = 0; ai < 2; ++ai)
#pragma unroll
            for (int m = 0; m < 4; ++m) { bf16_t* rowp = O + (size_t)(u.pm * 256 + ai * 128 + wr * 64 + m * 16 + fr) * ldc + u.pn * 256 + wc * 32 + 8 * fq;
#pragma unroll
                for (int bj = 0; bj < 2; ++bj) { const f32x4 v0 = acc[ai][bj][m][0], v1 = acc[ai][bj][m][1];
                    u32x4 w; w.x = pk2(v0[0], v0[1]); w.y = pk2(v0[2], v0[3]); w.z = pk2(v1[0], v1[1]); w.w = pk2(v1[2], v1[3]);
                    *(u32x4*)(rowp + bj * 128) = w; } }
        return false;
    }
};
struct EpiBf16Mid {
    static constexpr bool PERM = true;
    bf16_t* O; int ldc; const float* rtab;
    DI bool operator()(f32x4 (&acc)[2][2][4][2], const pg8::Unit& u, int wr, int wc, int fr, int fq) const {
        if (u.ks == 0) {
#pragma unroll
            for (int ai = 0; ai < 2; ++ai)
#pragma unroll
                for (int m = 0; m < 4; ++m) { const float r = rtab[u.pm * 256 + ai * 128 + wr * 64 + m * 16 + fr];
#pragma unroll
                    for (int bj = 0; bj < 2; ++bj) { acc[ai][bj][m][0] = acc[ai][bj][m][0] * r; acc[ai][bj][m][1] = acc[ai][bj][m][1] * r; } }
            return true;
        }
        EpiBf16 e{O, ldc}; return e(acc, u, wr, wc, fr, fq);
    }
};
struct EpiF32Part {
    static constexpr bool PERM = true;
    float* P;
    DI bool operator()(f32x4 (&acc)[2][2][4][2], const pg8::Unit& u, int wr, int wc, int fr, int fq) const {
        float* base = P + (size_t)(u.job * 8 + u.ks) * 2048 * 256;
#pragma unroll
        for (int ai = 0; ai < 2; ++ai)
#pragma unroll
            for (int m = 0; m < 4; ++m) { float* rowp = base + (size_t)(u.pm * 256 + ai * 128 + wr * 64 + m * 16 + fr) * 256 + wc * 32 + 8 * fq;
#pragma unroll
                for (int bj = 0; bj < 2; ++bj) { *(f32x4*)(rowp + bj * 128) = acc[ai][bj][m][0]; *(f32x4*)(rowp + bj * 128 + 4) = acc[ai][bj][m][1]; } }
        return false;
    }
};
template <int MODE> struct LACfg;
template <> struct LACfg<0> { static constexpr int CL = 64, NH = 1, HA = 1, NCH = 8; };
template <> struct LACfg<1> { static constexpr int CL = 32, NH = 2, HA = 2, NCH = 16; };
template <> struct LACfg<2> { static constexpr int CL = 64, NH = 1, HA = 4, NCH = 8; };
constexpr int LA_NSC = 16, LA_ITEMS = 128;
DI float log_sigmoid_(float x) { return fminf(x, 0.f) - __logf(1.0f + __expf(-fabsf(x))); }
DI float softplus_(float x) { return fmaxf(x, 0.f) + __logf(1.0f + __expf(-fabsf(x))); }

template <int MODE> DI void la_prep(const Frame& F, CArgs& a, int item) {
    typedef LACfg<MODE> C;
    constexpr int CL = C::CL, NH = C::NH, PQ = 272;
    constexpr int O_Q = 0, O_K = O_Q + NH * CL * PQ, O_RAW = O_K + NH * CL * PQ, O_GS = O_RAW + 4096;
    LAS unsigned char* L = F.lds; unsigned char* ws = a.ws; unsigned char* act = ws + WS_ACT;
    const int tid = F.tid;
    const int c = item % (SEQ / CL), bh = item / (SEQ / CL), b = bh >> 2, hx = bh & 3;
    const size_t tok0 = (size_t)b * SEQ + (size_t)c * CL;
    bf16_t* kg; bf16_t* qg; int ldk;
    if constexpr (MODE == 0) { kg = (bf16_t*)(act + A0_GK) + tok0 * 512 + hx * 128; qg = (bf16_t*)(act + A0_GQ) + tok0 * 512 + hx * 128; ldk = 512; }
    else { kg = (bf16_t*)(act + A1_HF) + tok0 * 1024 + hx * 256; qg = (bf16_t*)(act + A1_HQ) + tok0 * 1024 + hx * 256; ldk = 1024; }
    __syncthreads();
    { u32x4 kq[4];
#pragma unroll
        for (int i = 0; i < 2; ++i) { const int ci = tid + 512 * i, hh2 = (NH == 2) ? (ci >> 9) : 0, j = (ci >> 4) & (CL - 1), cc = ci & 15;
            kq[i] = *(const u32x4*)(kg + (size_t)j * ldk + hh2 * 128 + cc * 8); kq[2 + i] = *(const u32x4*)(qg + (size_t)j * ldk + hh2 * 128 + cc * 8); }
        f32x4 gr = {0.f, 0.f, 0.f, 0.f};
        if constexpr (MODE == 0) { if (tid < 256) gr = *(const f32x4*)((const float*)(act + A0_GLR) + tok0 * 16 + tid * 4); }
#pragma unroll
        for (int i = 0; i < 2; ++i) { const int ci = tid + 512 * i, hh2 = (NH == 2) ? (ci >> 9) : 0, j = (ci >> 4) & (CL - 1), cc = ci & 15;
            *(LAS u32x4*)(L + O_K + (hh2 * CL + j) * PQ + cc * 16) = kq[i]; *(LAS u32x4*)(L + O_Q + (hh2 * CL + j) * PQ + cc * 16) = kq[2 + i]; }
        if constexpr (MODE == 0) { if (tid < 256) *(LAS f32x4*)(L + O_RAW + tid * 16) = gr; } }
    if constexpr (MODE == 0) {
        const int d = tid & 127, jg = tid >> 7;
        float wu[16];
#pragma unroll
        for (int r = 0; r < 16; ++r) wu[r] = a.in[8][r * 512 + hx * 128 + d];
        const float bu = a.in[9][hx * 128 + d];
        __syncthreads();
        float lg[16]; float run = 0.f;
#pragma unroll
        for (int jj = 0; jj < 16; ++jj) { const LAS f32x4* gl = (const LAS f32x4*)(L + O_RAW + (jg * 16 + jj) * 64);
            const f32x4 g0 = gl[0], g1 = gl[1], g2 = gl[2], g3 = gl[3];
            float x = bu;
#pragma unroll
            for (int e = 0; e < 4; ++e) { x += g0[e] * wu[e]; x += g1[e] * wu[4 + e]; x += g2[e] * wu[8 + e]; x += g3[e] * wu[12 + e]; }
            run += log_sigmoid_(x) * (1.0f / 16.0f); lg[jj] = run; }
        ((LAS float*)(L + O_GS))[jg * 128 + d] = run;
        __syncthreads();
        float pre = 0.f, tot = 0.f;
#pragma unroll
        for (int g = 0; g < 4; ++g) { const float v = ((LAS float*)(L + O_GS))[g * 128 + d]; if (g < jg) pre += v; tot += v; }
        if (jg == 0) ((float*)(ws + WS_BL))[(size_t)item * 128 + d] = tot;
#pragma unroll
        for (int jj = 0; jj < 16; ++jj) { const int j = jg * 16 + jj; const float bb = pre + lg[jj];
            LAS unsigned short* kp = (LAS unsigned short*)(L + O_K + j * PQ + d * 2); LAS unsigned short* qp = (LAS unsigned short*)(L + O_Q + j * PQ + d * 2);
            const unsigned pk = pk2(bf2f(*kp) * __expf(-bb), bf2f(*qp) * __expf(bb)); *kp = (unsigned short)(pk & 0xffffu); *qp = (unsigned short)(pk >> 16); }
    } else {
        const int d = tid & 127, hh = (tid >> 7) & 1, jg = tid >> 8;
        const float lbv = ((const float*)(ws + WS_LB))[(2 * hx + hh) * 128 + d];
        __syncthreads();
        float lg[16], kk[16]; float run = 0.f;
#pragma unroll
        for (int jj = 0; jj < 16; ++jj) { const float z = bf2f(*(const LAS unsigned short*)(L + O_K + (hh * CL + jg * 16 + jj) * PQ + d * 2));
            const float sg = __builtin_amdgcn_rcpf(1.0f + __expf(-z));
            run += __logf(lbv + (1.f - lbv) * sg); lg[jj] = run; kk[jj] = (1.f - lbv) * (1.f - sg); }
        ((LAS float*)(L + O_GS))[jg * 256 + hh * 128 + d] = run;
        __syncthreads();
        const float g0 = ((LAS float*)(L + O_GS))[hh * 128 + d], g1 = ((LAS float*)(L + O_GS))[256 + hh * 128 + d];
        if (jg == 0) ((float*)(ws + WS_BL))[(size_t)item * 256 + hh * 128 + d] = g0 + g1;
        const float pre = jg ? g0 : 0.f;
#pragma unroll
        for (int jj = 0; jj < 16; ++jj) { const int j = jg * 16 + jj; const float bb = pre + lg[jj];
            LAS unsigned short* kp = (LAS unsigned short*)(L + O_K + (hh * CL + j) * PQ + d * 2); LAS unsigned short* qp = (LAS unsigned short*)(L + O_Q + (hh * CL + j) * PQ + d * 2);
            const unsigned pk = pk2(kk[jj] * __expf(-bb), bf2f(*qp) * __expf(bb)); *kp = (unsigned short)(pk & 0xffffu); *qp = (unsigned short)(pk >> 16); }
    }
    __syncthreads();
    {
        bf16_t* ktg = (bf16_t*)(ws + WS_HY) + (size_t)item * (NH * 128 * CL);
        constexpr int TPR = CL / 8;
#pragma unroll
        for (int i = 0; i < NH * 128 * TPR / NTHR; ++i) { const int pi = tid + NTHR * i, row = pi / TPR, pc = pi % TPR, hh2 = row >> 7, d = row & 127;
            unsigned wv[4];
#pragma unroll
            for (int e = 0; e < 4; ++e) { const unsigned lo = *(const LAS unsigned short*)(L + O_K + (hh2 * CL + pc * 8 + 2 * e) * PQ + d * 2), hi = *(const LAS unsigned short*)(L + O_K + (hh2 * CL + pc * 8 + 2 * e + 1) * PQ + d * 2); wv[e] = lo | (hi << 16); }
            *(u32x4*)(ktg + (size_t)row * CL + pc * 8) = (u32x4){wv[0], wv[1], wv[2], wv[3]}; } }
#pragma unroll
    for (int i = 0; i < 2; ++i) { const int ci = tid + 512 * i, hh2 = (NH == 2) ? (ci >> 9) : 0, j = (ci >> 4) & (CL - 1), cc = ci & 15;
        *(u32x4*)(kg + (size_t)j * ldk + hh2 * 128 + cc * 8) = *(const LAS u32x4*)(L + O_K + (hh2 * CL + j) * PQ + cc * 16);
        *(u32x4*)(qg + (size_t)j * ldk + hh2 * 128 + cc * 8) = *(const LAS u32x4*)(L + O_Q + (hh2 * CL + j) * PQ + cc * 16); }
}
DI float silu_fast(float x) { return x * __builtin_amdgcn_rcpf(1.0f + __expf(-x)); }
DI void ssd_prep(const Frame& F, CArgs& a) {
    unsigned char* ws = a.ws; unsigned char* act = ws + WS_ACT;
    const int gt = F.bid * NTHR + F.tid, NGT = F.G * NTHR;
    { u32x4 pn[4]; u32x2 hn = {0u, 0u}; float wn[5];
        auto ld = [&](int it) { const int ch = it >> 9, run = it & 511; const size_t t0 = (size_t)run * 32; const bf16_t* rp = (const bf16_t*)(act + A1_XST) + (size_t)ch * MTOK + t0;
#pragma unroll
            for (int q = 0; q < 4; ++q) pn[q] = *(const u32x4*)(rp + 8 * q);
            hn = (u32x2){0u, 0u}; if ((t0 & (SEQ - 1)) != 0) hn = *(const u32x2*)(rp - 4);
            wn[0] = a.in[21][ch]; wn[1] = a.in[21][1536 + ch]; wn[2] = a.in[21][2 * 1536 + ch]; wn[3] = a.in[21][3 * 1536 + ch]; wn[4] = a.in[22][ch]; };
        if (gt < 1024 * 512) ld(gt);
#pragma unroll 1
        for (int it = gt; it < 1024 * 512; it += NGT) { const int ch = it >> 9, run = it & 511; const size_t t0 = (size_t)run * 32;
            bf16_t* op = (bf16_t*)(ws + WS_OC) + (size_t)ch * MTOK + t0;
            u32x4 p[4];
#pragma unroll
            for (int q = 0; q < 4; ++q) p[q] = pn[q];
            const u32x2 h2 = hn; const float w0 = wn[0], w1 = wn[1], w2 = wn[2], w3 = wn[3], cb = wn[4];
            if (it + NGT < 1024 * 512) ld(it + NGT);
            float x0 = bfhi(h2.x), x1 = bflo(h2.y), x2 = bfhi(h2.y);
#pragma unroll
            for (int q = 0; q < 4; ++q) { unsigned o[4];
#pragma unroll
                for (int e = 0; e < 4; ++e) { const float xa = bflo(p[q][e]), xb = bfhi(p[q][e]);
                    const float ya = silu_fast(cb + w0 * x0 + w1 * x1 + w2 * x2 + w3 * xa), yb = silu_fast(cb + w0 * x1 + w1 * x2 + w2 * xa + w3 * xb);
                    x0 = x2; x1 = xa; x2 = xb; o[e] = pk2(ya, yb); }
                *(u32x4*)(op + 8 * q) = (u32x4){o[0], o[1], o[2], o[3]}; } } }
    for (int it = gt; it < 2048 * 64; it += NGT) { const int run = it >> 6, cg = it & 63; const size_t t0 = (size_t)run * 8;
        const bf16_t* rp = (const bf16_t*)(act + A1_BC) + t0 * 512 + cg * 8; bf16_t* op = (bf16_t*)(ws + WS_U0) + t0 * 512 + cg * 8;
        const int ch = 1024 + cg * 8;
        u32x4 r[11];
        const int tpos = (int)(t0 & (SEQ - 1));
#pragma unroll
        for (int k = 0; k < 11; ++k) { r[k] = (u32x4){0u, 0u, 0u, 0u}; if (tpos + k - 3 >= 0) r[k] = *(const u32x4*)(rp + (long)(k - 3) * 512); }
        f32x4 wa[4], wb[4]; const f32x4 ba = *(const f32x4*)(a.in[22] + ch), bb = *(const f32x4*)(a.in[22] + ch + 4);
#pragma unroll
        for (int k = 0; k < 4; ++k) { wa[k] = *(const f32x4*)(a.in[21] + k * 1536 + ch); wb[k] = *(const f32x4*)(a.in[21] + k * 1536 + ch + 4); }
        float yt[8][8];
#pragma unroll
        for (int t = 0; t < 8; ++t) { float y[8];
#pragma unroll
            for (int e = 0; e < 4; ++e) { float s0 = ba[e], s1 = bb[e];
#pragma unroll
                for (int k = 0; k < 4; ++k) { const u32x4 x = r[t + k]; const float xa = (e & 1) ? bfhi(x[e >> 1]) : bflo(x[e >> 1]); const float xb = (e & 1) ? bfhi(x[2 + (e >> 1)]) : bflo(x[2 + (e >> 1)]);
                    s0 += wa[k][e] * xa; s1 += wb[k][e] * xb; }
                y[e] = silu_fast(s0); y[4 + e] = silu_fast(s1); }
            *(u32x4*)(op + (size_t)t * 512) = (u32x4){pk2(y[0], y[1]), pk2(y[2], y[3]), pk2(y[4], y[5]), pk2(y[6], y[7])};
#pragma unroll
            for (int e = 0; e < 8; ++e) yt[e][t] = y[e]; }
        if (cg < 32) {
            const int g = cg >> 4, n0 = (cg & 15) * 8; const size_t ck = t0 >> 6; const int j0 = (int)(t0 & 63);
            bf16_t* bt = (bf16_t*)(ws + WS_HY + 32 * MiB) + ((ck * 2 + g) * 128 + n0) * 64 + j0;
#pragma unroll
            for (int e = 0; e < 8; ++e) *(u32x4*)(bt + e * 64) = (u32x4){pk2(yt[e][0], yt[e][1]), pk2(yt[e][2], yt[e][3]), pk2(yt[e][4], yt[e][5]), pk2(yt[e][6], yt[e][7])}; } }
    { const int gw = F.bid * NWAVES + F.wave, NGW = F.G * NWAVES, j = F.lane;
        for (int it = gw; it < 256 * 16; it += NGW) { const int head = it & 15, ck = it >> 4; const size_t gi = ((size_t)ck * 64 + j) * 16 + head;
            const float dtv = softplus_(((const float*)(act + A1_SDT))[gi] + a.in[23][head]);
            float bs = dtv * (-__expf(a.in[24][head]));
#pragma unroll
            for (int o = 1; o < 64; o <<= 1) { const float t = __shfl_up(bs, o); if (j >= o) bs += t; }
            const float bl = __shfl(bs, 63);
            ((float*)(act + A1_BS))[gi] = bs; ((float*)(act + A1_DTV))[gi] = dtv; ((float*)(act + A1_WJ))[gi] = __expf(bl - bs) * dtv; } }
}

DI void hgrn_prep_cols(const Frame& F, CArgs& a) {
    unsigned char* ws = a.ws; unsigned char* act = ws + WS_ACT;
    const int gt = F.bid * NTHR + F.tid, NGT = F.G * NTHR;
    constexpr int NIT = 2 * 8 * 256 * 64;
    auto addr = [&](int u, bf16_t*& zp, bf16_t*& qp) { const int idx = gt + (u >> 1) * NGT, hf = u & 1;
        const int d = (idx & 63) * 2, c = (idx >> 6) & 255, bhd = idx >> 14, head = bhd & 7, b = bhd >> 3;
        const size_t tok0 = (size_t)b * SEQ + (size_t)c * 32 + 16 * hf;
        zp = (bf16_t*)(act + A1_HF) + tok0 * 1024 + head * 128 + d; qp = (bf16_t*)(act + A1_HQ) + tok0 * 1024 + head * 128 + d; };
    const int nstep = 2 * ((NIT - gt + NGT - 1) / NGT);
    unsigned zn[16], qn[16];
    if (nstep > 0) { bf16_t* zp; bf16_t* qp; addr(0, zp, qp);
#pragma unroll
        for (int j = 0; j < 16; ++j) { zn[j] = *(const unsigned*)(zp + (size_t)j * 1024); qn[j] = *(const unsigned*)(qp + (size_t)j * 1024); } }
    float p0 = 1.f, p1 = 1.f;
#pragma unroll 1
    for (int u = 0; u < nstep; ++u) {
        const int idx = gt + (u >> 1) * NGT, hf = u & 1;
        const int d = (idx & 63) * 2, c = (idx >> 6) & 255, bhd = idx >> 14, head = bhd & 7, b = bhd >> 3;
        bf16_t* zp; bf16_t* qp; addr(u, zp, qp);
        unsigned zr[16], qr[16];
#pragma unroll
        for (int j = 0; j < 16; ++j) { zr[j] = zn[j]; qr[j] = qn[j]; }
        if (u + 1 < nstep) { bf16_t* zp2; bf16_t* qp2; addr(u + 1, zp2, qp2);
#pragma unroll
            for (int j = 0; j < 16; ++j) { zn[j] = *(const unsigned*)(zp2 + (size_t)j * 1024); qn[j] = *(const unsigned*)(qp2 + (size_t)j * 1024); } }
        const f32x2 lbv = *(const f32x2*)((const float*)(ws + WS_LB) + head * 128 + d);
        if (hf == 0) { p0 = 1.f; p1 = 1.f; }
        unsigned kt0[8], kt1[8];
#pragma unroll
        for (int j = 0; j < 16; ++j) {
            const float e0 = __expf(-bflo(zr[j])), e1 = __expf(-bfhi(zr[j]));
            const float sg0 = __builtin_amdgcn_rcpf(1.0f + e0), sg1 = __builtin_amdgcn_rcpf(1.0f + e1);
            p0 *= lbv.x + (1.f - lbv.x) * sg0; p1 *= lbv.y + (1.f - lbv.y) * sg1;
            const unsigned kk = pk2((1.f - lbv.x) * (1.f - sg0) * __builtin_amdgcn_rcpf(p0), (1.f - lbv.y) * (1.f - sg1) * __builtin_amdgcn_rcpf(p1));
            const unsigned qq = pk2(bflo(qr[j]) * p0, bfhi(qr[j]) * p1);
            *(unsigned*)(zp + (size_t)j * 1024) = kk; *(unsigned*)(qp + (size_t)j * 1024) = qq;
            if (j & 1) { kt0[j >> 1] |= (kk & 0xffffu) << 16; kt1[j >> 1] |= kk & 0xffff0000u; } else { kt0[j >> 1] = kk & 0xffffu; kt1[j >> 1] = kk >> 16; } }
        const int citem = (b * 4 + (head >> 1)) * 256 + c;
        bf16_t* ktg = (bf16_t*)(ws + WS_HY) + (size_t)citem * (2 * 128 * 32) + (size_t)((head & 1) * 128 + d) * 32;
#pragma unroll
        for (int q = 0; q < 2; ++q) { *(u32x4*)(ktg + 16 * hf + 8 * q) = (u32x4){kt0[4 * q], kt0[4 * q + 1], kt0[4 * q + 2], kt0[4 * q + 3]};
            *(u32x4*)(ktg + 32 + 16 * hf + 8 * q) = (u32x4){kt1[4 * q], kt1[4 * q + 1], kt1[4 * q + 2], kt1[4 * q + 3]}; }
        if (hf == 1) *(f32x2*)((float*)(ws + WS_BL) + (size_t)citem * 256 + (head & 1) * 128 + d) = (f32x2){__logf(p0), __logf(p1)};
    }
}
template <int MODE, int PHASE, bool SCANNED = false> DI void la_phase(const Frame& F, CArgs& a, int item_first, int item_stride) {
    typedef LACfg<MODE> C;
    constexpr int CL = C::CL, NH = C::NH, HA = C::HA, NI = CL / 32, PQ = 272  , PJ = (CL + 8) * 2  ;
    constexpr int O_QH = 0, O_KH = O_QH + NH * CL * PQ, O_KT = O_KH + NH * CL * PQ, O_VT = O_KT + NH * 128 * PJ, O_ATT = O_VT + 256 * PJ, O_DEC = O_ATT + HA * CL * PJ,
                  O_GS = O_DEC + 1024, O_RED = O_GS + 4096, O_BS = O_RED + 2048, O_DT = O_BS + 1024, O_WJ = O_DT + 1024, O_LS = O_WJ + 1024, O_ENDL = O_LS + 1024;
    static_assert(O_ENDL <= RING_BYTES, "LA LDS");
    LAS unsigned char* L = F.lds;
    unsigned char* ws = a.ws; unsigned char* act = ws + WS_ACT;
    const int tid0 = F.tid, w = F.wave;
#define LAUNDER() int tid = tid0; asm volatile("" : "+v"(tid)); const int lane = tid & 63, r32 = lane & 31, h = lane >> 5; (void)lane; (void)r32; (void)h
    float* Ubase = (float*)(ws + (MODE == 0 ? WS_U0 : (MODE == 1 ? WS_OW : WS_OW + 16 * MiB)));
    float* LOGD = (float*)(ws + WS_LOGD) + (size_t)MODE * LA_ITEMS * 256;
    const int hk = (MODE == 1) ? (w >> 2) : 0;
    const int hs = (MODE == 2) ? (w >> 1) : 0;
#pragma unroll 1
    for (int item = item_first; item < LA_ITEMS; item += item_stride) {
        const int sc = item & 15, bh = item >> 4, b = bh >> 2, hx = bh & 3;
        PROF(63);
        f32x16 S[4];
#pragma unroll
        for (int dt = 0; dt < 4; ++dt)
#pragma unroll
            for (int r = 0; r < 16; ++r) S[dt][r] = 0.f;
        if constexpr (PHASE == 1 && SCANNED) { LAUNDER();
            if (sc > 0) { const float* U = Ubase + (size_t)(item - 1) * 32768 + (size_t)w * 4096 + lane;
#pragma unroll
                for (int dt = 0; dt < 4; ++dt)
#pragma unroll
                    for (int r = 0; r < 16; ++r) S[dt][r] = U[(dt * 16 + r) * 64]; }
        }
        if constexpr (PHASE == 1 && !SCANNED) { LAUNDER();
            LAS float* FD = (LAS float*)L;
            __syncthreads();
            for (int e2 = tid; e2 < sc * 256; e2 += NTHR) FD[e2] = __expf(LOGD[(size_t)(bh << 4) * 256 + e2]);
            __syncthreads();
#pragma unroll 2
            for (int sp = 0; sp < sc; ++sp) {
                const float* U = Ubase + (size_t)((bh << 4) + sp) * 32768 + (size_t)w * 4096 + lane;
                float u[64];
#pragma unroll
                for (int k = 0; k < 64; ++k) u[k] = U[k * 64];
#pragma unroll
                for (int dt = 0; dt < 4; ++dt)
#pragma unroll
                    for (int q = 0; q < 4; ++q) {
                        f32x4 f;
                        if constexpr (MODE == 2) { const float fs = FD[sp * 256 + hs]; f = (f32x4){fs, fs, fs, fs}; } else f = *(const LAS f32x4*)(FD + sp * 256 + hk * 128 + 32 * dt + crow(4 * q, h));
#pragma unroll
                        for (int e2 = 0; e2 < 4; ++e2) S[dt][4 * q + e2] = S[dt][4 * q + e2] * f[e2] + u[dt * 16 + 4 * q + e2];
                    }
            }
            __syncthreads();
        }
        { LAUNDER();
        if (tid < 256) ((LAS float*)(L + O_LS))[tid] = 0.f; }
        __syncthreads();
        constexpr int CPR = CL / 8, NVQ = 256 * CPR / NTHR;
        u32x4 kr[2], qr[2], vr[NVQ], ktr[2]; float sg0 = 0.f, sg1 = 0.f, sg2 = 0.f;
        u32x2 gzr[NI][4];
        f32x4 nwr[4];
        (void)gzr; (void)nwr;
#define STG_LOAD(cc_) do { const int c_ = (cc_); const size_t tk = (size_t)b * SEQ + sc * 512 + c_ * CL; const int citem = (b * 4 + hx) * (SEQ / CL) + sc * C::NCH + c_; \
            const bf16_t* ksrc; const bf16_t* qsrc; int ldk; \
            if constexpr (MODE == 0) { ksrc = (const bf16_t*)(act + A0_GK) + tk * 512 + hx * 128; qsrc = (const bf16_t*)(act + A0_GQ) + tk * 512 + hx * 128; ldk = 512; } \
            else if constexpr (MODE == 1) { ksrc = (const bf16_t*)(act + A1_HF) + tk * 1024 + hx * 256; qsrc = (const bf16_t*)(act + A1_HQ) + tk * 1024 + hx * 256; ldk = 1024; } \
            else { ksrc = (const bf16_t*)(ws + WS_U0) + tk * 512 + (hx >> 1) * 128; qsrc = ksrc + 256; ldk = 512; } \
            const bf16_t* vsrc = (MODE == 0) ? (const bf16_t*)(act + A0_GVT) + (size_t)(hx * 256) * MTOK + tk : (MODE == 1) ? (const bf16_t*)(act + A1_HIT) + (size_t)(hx * 256) * MTOK + tk \
                                                                                                              : (const bf16_t*)(ws + WS_OC) + (size_t)(hx * 256) * MTOK + tk; \
            _Pragma("unroll") for (int i = 0; i < 2; ++i) { const int ci = tid + 512 * i, hh2 = (NH == 2) ? (ci >> 9) : 0, j = (ci >> 4) & (CL - 1), cc = ci & 15; \
                if constexpr (PHASE == 1) { kr[i] = *(const u32x4*)(ksrc + (size_t)j * ldk + hh2 * 128 + cc * 8); qr[i] = *(const u32x4*)(qsrc + (size_t)j * ldk + hh2 * 128 + cc * 8); } } \
            { const bf16_t* ktsrc = (MODE == 2) ? (const bf16_t*)(ws + WS_HY + 32 * MiB) + ((tk >> 6) * 2 + (hx >> 1)) * (128 * 64) : (const bf16_t*)(ws + WS_HY) + (size_t)citem * (NH * 128 * CL); \
              _Pragma("unroll") for (int i = 0; i < 2; ++i) ktr[i] = *(const u32x4*)(ktsrc + (size_t)(tid + 512 * i) * 8); } \
            _Pragma("unroll") for (int q = 0; q < NVQ; ++q) { const int ci = q * NTHR + tid, v = ci / CPR, cc = ci % CPR; vr[q] = *(const u32x4*)(vsrc + (size_t)v * MTOK + cc * 8); } \
            if constexpr (MODE == 2) { if (tid < 256) { const size_t gi = (tk + (tid & 63)) * 16 + 4 * hx + (tid >> 6); sg0 = ((const float*)(act + A1_BS))[gi]; sg1 = ((const float*)(act + A1_DTV))[gi]; sg2 = ((const float*)(act + A1_WJ))[gi]; } } \
            else { if (tid < NH * 128) sg0 = ((const float*)(ws + WS_BL))[(size_t)citem * (NH * 128) + tid]; } } while (0)
#define STG_STORE() do { \
            if constexpr (MODE == 2) { if (tid < 256) { const int hh = tid >> 6, j = tid & 63; const float bl = __shfl(sg0, 63); \
                    ((LAS float*)(L + O_BS))[hh * 64 + j] = sg0; ((LAS float*)(L + O_DT))[hh * 64 + j] = sg1; ((LAS float*)(L + O_WJ))[hh * 64 + j] = sg2; \
                    if (j == 0) { ((LAS float*)(L + O_DEC))[hh] = __expf(bl); ((LAS float*)(L + O_LS))[hh] += bl; } } } \
            else { if (tid < NH * 128) { ((LAS float*)(L + O_DEC))[tid] = __expf(sg0); ((LAS float*)(L + O_LS))[tid] += sg0; } } \
            _Pragma("unroll") for (int i = 0; i < 2; ++i) { const int ci = tid + 512 * i, hh2 = (NH == 2) ? (ci >> 9) : 0, j = (ci >> 4) & (CL - 1), cc = ci & 15; \
                if constexpr (PHASE == 1) { *(LAS u32x4*)(L + O_KH + (hh2 * CL + j) * PQ + cc * 16) = kr[i]; *(LAS u32x4*)(L + O_QH + (hh2 * CL + j) * PQ + cc * 16) = qr[i]; } \
                { constexpr int TPR = CL / 8; const int pi = tid + 512 * i, row = pi / TPR, pc = pi % TPR; *(LAS u32x4*)(L + O_KT + row * PJ + pc * 16) = ktr[i]; } } \
            _Pragma("unroll") for (int q = 0; q < NVQ; ++q) { const int ci = q * NTHR + tid, v = ci / CPR, cc = ci % CPR; *(LAS u32x4*)(L + O_VT + v * PJ + cc * 16) = vr[q]; } } while (0)
        PROF(MODE * 20 + PHASE * 10 + 0);
        if constexpr (PHASE == 1 && MODE != 2) { LAUNDER();
#pragma unroll
            for (int q = 0; q < 4; ++q) { const int vv = 32 * w + crow(4 * q, h); nwr[q] = *(const f32x4*)((MODE == 0 ? a.in[10] : a.in[20]) + ((MODE == 0) ? vv : (vv & 127))); } }
        { LAUNDER(); STG_LOAD(0); }
#pragma unroll 1
        for (int c = 0; c < C::NCH; ++c) {
            const int tpos = sc * 512 + c * CL;
            const size_t tok0 = (size_t)b * SEQ + tpos;
            { LAUNDER();
            STG_STORE();
            }
            __syncthreads();
            PROF(MODE * 20 + PHASE * 10 + 1);
            if (c + 1 < C::NCH) { LAUNDER(); STG_LOAD(c + 1); }
            if constexpr (PHASE == 1) { LAUNDER();
                const bf16_t* gbase = (MODE == 0) ? (const bf16_t*)(act + A0_GZ) + hx * 256 : (MODE == 1) ? (const bf16_t*)(act + A1_HZ) + hx * 256 : (const bf16_t*)(act + A1_SZ) + hx * 256;
#pragma unroll
                for (int ni = 0; ni < NI; ++ni)
#pragma unroll
                    for (int q = 0; q < 4; ++q) gzr[ni][q] = *(const u32x2*)(gbase + (tok0 + 32 * ni + r32) * 1024 + 32 * w + crow(4 * q, h)); }
            f32x16 oT[NI];
            if constexpr (PHASE == 1) {
                { LAUNDER();
                if constexpr (MODE == 0 || MODE == 2) {
                    if (w < 3) { const int mj = (w == 2), ni = (w >= 1);
                        f32x16 t;
#pragma unroll
                        for (int r = 0; r < 16; ++r) t[r] = 0.f;
                        { bf16x8 fa[8], fb[8];
                            __builtin_amdgcn_sched_barrier(0);
#pragma unroll
                            for (int s = 0; s < 8; ++s) { fa[s] = *(const LAS bf16x8*)(L + O_KH + (32 * mj + r32) * PQ + (16 * s + 8 * h) * 2); fb[s] = *(const LAS bf16x8*)(L + O_QH + (32 * ni + r32) * PQ + (16 * s + 8 * h) * 2); }
                            __builtin_amdgcn_sched_barrier(0);
                            __builtin_amdgcn_s_setprio(2);
#pragma unroll
                            for (int s = 0; s < 8; ++s) t = MFMA32(fa[s], fb[s], t);
                            __builtin_amdgcn_s_setprio(0);
                            __builtin_amdgcn_sched_barrier(0); }
                        const int i = 32 * ni + r32;
#pragma unroll
                        for (int hh = 0; hh < HA; ++hh) {
                            float bsi = 0.f; if constexpr (MODE == 2) bsi = ((LAS float*)(L + O_BS))[hh * 64 + i];
#pragma unroll
                            for (int q = 0; q < 4; ++q) { float o[4];
#pragma unroll
                                for (int e = 0; e < 4; ++e) { const int j = 32 * mj + crow(4 * q + e, h); float v = t[4 * q + e];
                                    if constexpr (MODE == 2) v *= __expf(fminf(bsi - ((LAS float*)(L + O_BS))[hh * 64 + j], 0.f)) * ((LAS float*)(L + O_DT))[hh * 64 + j];
                                    o[e] = (j <= i) ? v : 0.f; }
                                *(LAS u32x2*)(L + O_ATT + (hh * CL + i) * PJ + (32 * mj + crow(4 * q, h)) * 2) = (u32x2){pk2(o[0], o[1]), pk2(o[2], o[3])}; } }
                    }
                } else {
                    if (w < 2) { f32x16 t;
#pragma unroll
                        for (int r = 0; r < 16; ++r) t[r] = 0.f;
                        { bf16x8 fa[8], fb[8];
                            __builtin_amdgcn_sched_barrier(0);
#pragma unroll
                            for (int s = 0; s < 8; ++s) { fa[s] = *(const LAS bf16x8*)(L + O_KH + (w * CL + r32) * PQ + (16 * s + 8 * h) * 2); fb[s] = *(const LAS bf16x8*)(L + O_QH + (w * CL + r32) * PQ + (16 * s + 8 * h) * 2); }
                            __builtin_amdgcn_sched_barrier(0);
                            __builtin_amdgcn_s_setprio(2);
#pragma unroll
                            for (int s = 0; s < 8; ++s) t = MFMA32(fa[s], fb[s], t);
                            __builtin_amdgcn_s_setprio(0);
                            __builtin_amdgcn_sched_barrier(0); }
#pragma unroll
                        for (int q = 0; q < 4; ++q) { float o[4];
#pragma unroll
                            for (int e = 0; e < 4; ++e) { const int j = crow(4 * q + e, h); o[e] = (j <= r32) ? t[4 * q + e] : 0.f; }
                            *(LAS u32x2*)(L + O_ATT + (w * CL + r32) * PJ + crow(4 * q, h) * 2) = (u32x2){pk2(o[0], o[1]), pk2(o[2], o[3])}; }
                    }
                }
                }
                { LAUNDER();
#pragma unroll
                for (int ni = 0; ni < NI; ++ni) {
#pragma unroll
                    for (int r = 0; r < 16; ++r) oT[ni][r] = 0.f;
                    bf16x8 fb[8];
                    __builtin_amdgcn_sched_barrier(0);
#pragma unroll
                    for (int ds = 0; ds < 8; ++ds) { const LAS unsigned char* qp = L + O_QH + (hk * CL + 32 * ni + r32) * PQ + (16 * ds + 4 * h) * 2;
                        const u32x2 lo = *(const LAS u32x2*)qp, hi = *(const LAS u32x2*)(qp + 16); fb[ds] = __builtin_bit_cast(bf16x8, (u32x4){lo.x, lo.y, hi.x, hi.y}); }
                    __builtin_amdgcn_sched_barrier(0);
#pragma unroll
                    for (int ds = 0; ds < 8; ++ds) { const int dt = ds >> 1, s = ds & 1; u32x4 p;
#pragma unroll
                        for (int e = 0; e < 4; ++e) p[e] = pk2(S[dt][8 * s + 2 * e], S[dt][8 * s + 2 * e + 1]);
                        oT[ni] = MFMA32(__builtin_bit_cast(bf16x8, p), fb[ds], oT[ni]); }
                    __builtin_amdgcn_sched_barrier(0);
                    if constexpr (MODE == 2) { const float e = __expf(((LAS float*)(L + O_BS))[hs * 64 + 32 * ni + r32]);
#pragma unroll
                        for (int r = 0; r < 16; ++r) oT[ni][r] *= e; }
                }
                }
                __syncthreads();
                PROF(MODE * 20 + PHASE * 10 + 2);
                { LAUNDER();
                const int ha = (MODE == 0) ? 0 : (MODE == 1 ? (w >> 2) : (w >> 1));
#pragma unroll
                for (int ni = 0; ni < NI; ++ni) { bf16x8 fa[2 * (NI)], fb[2 * (NI)];
                    __builtin_amdgcn_sched_barrier(0);
#pragma unroll
                    for (int s = 0; s < 2 * (ni + 1); ++s) { fa[s] = *(const LAS bf16x8*)(L + O_VT + (32 * w + r32) * PJ + (16 * s + 8 * h) * 2);
                        fb[s] = *(const LAS bf16x8*)(L + O_ATT + (ha * CL + 32 * ni + r32) * PJ + (16 * s + 8 * h) * 2); }
                    __builtin_amdgcn_sched_barrier(0);
                    __builtin_amdgcn_s_setprio(2);
#pragma unroll
                    for (int s = 0; s < 2 * (ni + 1); ++s) oT[ni] = MFMA32(fa[s], fb[s], oT[ni]);
                    __builtin_amdgcn_s_setprio(0);
                    __builtin_amdgcn_sched_barrier(0); }
                }
            }
            PROF(MODE * 20 + PHASE * 10 + 3);
            { LAUNDER();
            if constexpr (MODE == 2) { const float dsc = ((LAS float*)(L + O_DEC))[hs];
#pragma unroll
                for (int dt = 0; dt < 4; ++dt)
#pragma unroll
                    for (int r = 0; r < 16; ++r) S[dt][r] *= dsc; }
#pragma unroll
            for (int s = 0; s < CL / 16; ++s) { bf16x8 B, A[4]; float wj[8];
                __builtin_amdgcn_sched_barrier(0);
                B = *(const LAS bf16x8*)(L + O_VT + (32 * w + r32) * PJ + (16 * s + 8 * h) * 2);
#pragma unroll
                for (int dt = 0; dt < 4; ++dt) A[dt] = *(const LAS bf16x8*)(L + O_KT + (hk * 128 + 32 * dt + r32) * PJ + (16 * s + 8 * h) * 2);
                if constexpr (MODE == 2) { const f32x4 wa = *(const LAS f32x4*)(L + O_WJ + (hs * 64 + 16 * s + 8 * h) * 4), wb = *(const LAS f32x4*)(L + O_WJ + (hs * 64 + 16 * s + 8 * h + 4) * 4);
#pragma unroll
                    for (int e = 0; e < 4; ++e) { wj[e] = wa[e]; wj[4 + e] = wb[e]; } }
                __builtin_amdgcn_sched_barrier(0);
#pragma unroll
                for (int dt = 0; dt < 4; ++dt) {
                    if constexpr (MODE == 2) { const u32x4 ap = __builtin_bit_cast(u32x4, A[dt]); u32x4 o;
#pragma unroll
                        for (int e = 0; e < 4; ++e) o[e] = pk2(bflo(ap[e]) * wj[2 * e], bfhi(ap[e]) * wj[2 * e + 1]);
                        A[dt] = __builtin_bit_cast(bf16x8, o); }
                    S[dt] = MFMA32(A[dt], B, S[dt]); }
                __builtin_amdgcn_sched_barrier(0); }
            if constexpr (MODE != 2) {
#pragma unroll
                for (int dt = 0; dt < 4; ++dt)
#pragma unroll
                    for (int q = 0; q < 4; ++q) { const f32x4 f = *(const LAS f32x4*)(L + O_DEC + (hk * 128 + 32 * dt + crow(4 * q, h)) * 4);
#pragma unroll
                        for (int e = 0; e < 4; ++e) S[dt][4 * q + e] *= f[e]; } }
            }
            PROF(MODE * 20 + PHASE * 10 + 4);
            if constexpr (PHASE == 1) { LAUNDER();
                float part[NI];
                if constexpr (MODE == 2) {
                    const int head = 4 * hx + hs; const float Dh = a.in[25][head];
#pragma unroll
                    for (int ni = 0; ni < NI; ++ni) { const int i = 32 * ni + r32; const size_t tok = tok0 + i; float ss = 0.f;
#pragma unroll
                        for (int q = 0; q < 4; ++q) { const int vv = 32 * w + crow(4 * q, h);
                            const u32x2 zz = gzr[ni][q];
                            const float zf[4] = {bflo(zz.x), bfhi(zz.x), bflo(zz.y), bfhi(zz.y)}; float o[4];
#pragma unroll
                            for (int e = 0; e < 4; ++e) { const float xs = bf2f(*(const LAS unsigned short*)(L + O_VT + (vv + e) * PJ + i * 2));
                                o[e] = (oT[ni][4 * q + e] + Dh * xs) * silu_fast(zf[e]); ss += o[e] * o[e]; }
                            *(u32x2*)((bf16_t*)(ws + WS_CONCAT) + tok * 2048 + hx * 256 + vv) = (u32x2){pk2(o[0], o[1]), pk2(o[2], o[3])}; }
                        ss = half_sum(ss); part[ni] = ss;
                        if (h == 0) ((LAS float*)(L + O_RED))[w * 64 + i] = ss; }
                    __syncthreads();
                    if ((w & 1) == 0 && h == 0) {
#pragma unroll
                        for (int ni = 0; ni < NI; ++ni) { const int i = 32 * ni + r32; ((float*)(ws + WS_SSQ))[(tok0 + i) * 16 + head] = part[ni] + ((LAS float*)(L + O_RED))[(w + 1) * 64 + i]; } }
                } else {
#pragma unroll
                    for (int ni = 0; ni < NI; ++ni) { float ss = 0.f;
#pragma unroll
                        for (int r = 0; r < 16; ++r) ss += oT[ni][r] * oT[ni][r];
                        ss = half_sum(ss); if (h == 0) ((LAS float*)(L + O_RED))[w * 64 + 32 * ni + r32] = ss; }
                    __syncthreads();
#pragma unroll
                    for (int ni = 0; ni < NI; ++ni) { const int i = 32 * ni + r32; const size_t tok = tok0 + i; float tot = 0.f;
                        if constexpr (MODE == 0) {
#pragma unroll
                            for (int ww = 0; ww < 8; ++ww) tot += ((LAS float*)(L + O_RED))[ww * 64 + i];
                        } else {
#pragma unroll
                            for (int ww = 0; ww < 4; ++ww) tot += ((LAS float*)(L + O_RED))[((w & 4) + ww) * 64 + i];
                        }
                        const float rs = __builtin_amdgcn_rsqf(tot * (MODE == 0 ? 1.0f / 256.0f : 1.0f / 128.0f) + EPS);
#pragma unroll
                        for (int q = 0; q < 4; ++q) {
                            const int vv = 32 * w + crow(4 * q, h);
                            const u32x2 zz = gzr[ni][q]; const float zf[4] = {bflo(zz.x), bfhi(zz.x), bflo(zz.y), bfhi(zz.y)}; float o[4];
#pragma unroll
                            for (int e = 0; e < 4; ++e) o[e] = oT[ni][4 * q + e] * rs * nwr[q][e] * silu_fast(zf[e]);
                            bf16_t* dst = (bf16_t*)(ws + WS_CONCAT) + tok * 2048 + (MODE == 0 ? 0 : 1024) + hx * 256 + vv;
                            *(u32x2*)dst = (u32x2){pk2(o[0], o[1]), pk2(o[2], o[3])}; } }
                }
            }
            __syncthreads();
            PROF(MODE * 20 + PHASE * 10 + 5);
        }
        if constexpr (PHASE == 0) { LAUNDER();
            float* U = Ubase + (size_t)item * 32768 + (size_t)w * 4096 + lane;
#pragma unroll
            for (int dt = 0; dt < 4; ++dt)
#pragma unroll
                for (int r = 0; r < 16; ++r) U[(dt * 16 + r) * 64] = S[dt][r];
            if (tid < 256) LOGD[(size_t)item * 256 + tid] = ((LAS float*)(L + O_LS))[tid];
        }
        __syncthreads();
    }
}
#undef LAUNDER
#undef STG_LOAD
#undef STG_STORE

template <int MODE> DI void la_scan_item(const Frame& F, CArgs& a, int bh, int ws_) {
    unsigned char* ws = a.ws;
    float* Ubase = (float*)(ws + (MODE == 1 ? WS_OW : WS_OW + 16 * MiB));
    const float* LOGD = (const float*)(ws + WS_LOGD) + (size_t)MODE * LA_ITEMS * 256;
    const int lane = F.lane, h = lane >> 5, rw = F.wave;
    float s[8];
#pragma unroll
    for (int k = 0; k < 8; ++k) s[k] = 0.f;
#pragma unroll 1
    for (int half8 = 0; half8 < 2; ++half8) {
        float u[8][8], f[8][8];
#pragma unroll
        for (int i = 0; i < 8; ++i) { const int sc = half8 * 8 + i;
            const float* U = Ubase + (size_t)((bh << 4) + sc) * 32768 + (size_t)ws_ * 4096 + lane; const float* ld = LOGD + (size_t)((bh << 4) + sc) * 256;
#pragma unroll
            for (int k = 0; k < 8; ++k) { const int reg = 8 * rw + k, dt = reg >> 4, r = reg & 15; u[i][k] = U[reg * 64];
                f[i][k] = (MODE == 2) ? ld[ws_ >> 1] : ld[(ws_ >> 2) * 128 + 32 * dt + crow(r, h)]; } }
#pragma unroll
        for (int i = 0; i < 8; ++i) { const int sc = half8 * 8 + i; float* U = Ubase + (size_t)((bh << 4) + sc) * 32768 + (size_t)ws_ * 4096 + lane;
#pragma unroll
            for (int k = 0; k < 8; ++k) { s[k] = s[k] * __expf(f[i][k]) + u[i][k]; U[(8 * rw + k) * 64] = s[k]; } }
    }
}
constexpr int NSA_KP = 272, NSA_VP = 144;
constexpr int NL_K = 0, NL_V = NL_K + 64 * NSA_KP, NL_BUF = NL_V + 128 * NSA_VP  , NL_IMP = 2 * NL_BUF, NL_SEL = NL_IMP + 2 * 8 * 8 * 132 * 4, NL_QI = NL_SEL + 64 * 16, NL_END = NL_QI + 64;
static_assert(NL_END <= RING_BYTES, "NSA LDS");
constexpr float NEG_BIG = -1e30f;

struct NsaTile { u32x4 k0, k1, v0, v1; };
DI void nsa_tile_load(NsaTile& T, const bf16_t* Kg  , const bf16_t* Vg  , int ldv, int t, int tid) {
    const int c0 = tid, c1 = tid + 512;
    T.k0 = *(const u32x4*)(Kg + (size_t)(64 * t + (c0 >> 4)) * 128 + (c0 & 15) * 8);
    T.k1 = *(const u32x4*)(Kg + (size_t)(64 * t + (c1 >> 4)) * 128 + (c1 & 15) * 8);
    T.v0 = *(const u32x4*)(Vg + (size_t)(c0 >> 3) * ldv + 64 * t + (c0 & 7) * 8);
    T.v1 = *(const u32x4*)(Vg + (size_t)(c1 >> 3) * ldv + 64 * t + (c1 & 7) * 8);
}
DI void nsa_tile_store(const NsaTile& T, LAS unsigned char* L  , int tid) {
    const int c0 = tid, c1 = tid + 512;
    *(LAS u32x4*)(L + NL_K + (c0 >> 4) * NSA_KP + (c0 & 15) * 16) = T.k0;
    *(LAS u32x4*)(L + NL_K + (c1 >> 4) * NSA_KP + (c1 & 15) * 16) = T.k1;
    { const int cc = c0 & 7; LAS unsigned char* p = L + NL_V + (c0 >> 3) * NSA_VP + (cc >> 1) * 32 + (cc & 1) * 8;
        *(LAS u32x2*)p = (u32x2){T.v0.x, T.v0.y}; *(LAS u32x2*)(p + 16) = (u32x2){T.v0.z, T.v0.w}; }
    { const int cc = c1 & 7; LAS unsigned char* p = L + NL_V + (c1 >> 3) * NSA_VP + (cc >> 1) * 32 + (cc & 1) * 8;
        *(LAS u32x2*)p = (u32x2){T.v1.x, T.v1.y}; *(LAS u32x2*)(p + 16) = (u32x2){T.v1.z, T.v1.w}; }
}
DI void nsa_scores(f32x16 (&sT)[2], const bf16x8 (&qf)[8], LAS unsigned char* L, int r32, int h) {
    __builtin_amdgcn_s_setprio(2);
#pragma unroll
    for (int mt = 0; mt < 2; ++mt) {
#pragma unroll
        for (int r = 0; r < 16; ++r) sT[mt][r] = 0.f;
#pragma unroll
        for (int s = 0; s < 8; ++s) { const bf16x8 A = *(const LAS bf16x8*)(L + NL_K + (32 * mt + r32) * NSA_KP + (16 * s + 8 * h) * 2); sT[mt] = MFMA32(A, qf[s], sT[mt]); }
    }
    __builtin_amdgcn_s_setprio(0);
}
struct NsaState { f32x16 O[4]; float m, l; };
template <int BR> DI bool nsa_valid(int kk  , int tq  , int t, int qb, bool lane_sel) {
    if constexpr (BR == 0) return (16 * kk + 31 <= tq) && (kk <= 510);
    else if constexpr (BR == 1) return lane_sel && (kk <= tq);
    else return (kk <= tq) && (kk > tq - 512);
}
constexpr float NSA_THR = 10.0f;
DI bf16x8 nsa_ldk(LAS unsigned char* L, int mt, int s, int r32, int h) { return *(const LAS bf16x8*)(L + NL_K + (32 * mt + r32) * NSA_KP + (16 * s + 8 * h) * 2); }
DI bf16x8 nsa_ldv(LAS unsigned char* L, int dt, int g  , int r32, int h) {
    return *(const LAS bf16x8*)(L + NL_V + (32 * dt + r32) * NSA_VP + (16 * g + 8 * h) * 2);
}
template <int BR> DI void nsa_tile_compute(NsaState& st, const bf16x8 (&qf)[8], LAS unsigned char* L, int t, int tq, bool lane_sel, bool edge, int r32, int h) {
    f32x16 sT[2];
    const float nm = (BR == 1 && !lane_sel) ? NEG_BIG : -st.m;
#pragma unroll
    for (int mt = 0; mt < 2; ++mt)
#pragma unroll
        for (int r = 0; r < 16; ++r) sT[mt][r] = nm;
    bf16x8 ka[8], kb[8];
    __builtin_amdgcn_sched_barrier(0);
#pragma unroll
    for (int s = 0; s < 8; ++s) ka[s] = nsa_ldk(L, 0, s, r32, h);
    __builtin_amdgcn_sched_barrier(0);
    __builtin_amdgcn_s_setprio(2);
#pragma unroll
    for (int s = 0; s < 8; ++s) { kb[s] = nsa_ldk(L, 1, s, r32, h); sT[0] = MFMA32(ka[s], qf[s], sT[0]); }
    __builtin_amdgcn_sched_barrier(0);
    bf16x8 va[4], vb[4];
#pragma unroll
    for (int s = 0; s < 8; ++s) { if (s < 4) va[s] = nsa_ldv(L, s, 0, r32, h); sT[1] = MFMA32(kb[s], qf[s], sT[1]); }
    __builtin_amdgcn_s_setprio(0);
    __builtin_amdgcn_sched_barrier(0);
    if (edge) {
#pragma unroll
        for (int mt = 0; mt < 2; ++mt)
#pragma unroll
            for (int r = 0; r < 16; ++r) { const int kk = 64 * t + 32 * mt + crow(r, h); const bool ok = nsa_valid<BR>(kk, tq, t, 0, true); sT[mt][r] = ok ? sT[mt][r] : NEG_BIG; }
    }
    float rm = fmaxf(sT[0][0], sT[1][0]);
#pragma unroll
    for (int r = 1; r < 16; ++r) rm = fmaxf(rm, fmaxf(sT[0][r], sT[1][r]));
    if (__any(rm > NSA_THR)) {
        rm = half_max(rm);
        const float dl = fmaxf(rm, 0.f), alpha = fast_exp2(-dl);
        st.m += dl; st.l *= alpha;
#pragma unroll
        for (int mt = 0; mt < 2; ++mt)
#pragma unroll
            for (int r = 0; r < 16; ++r) sT[mt][r] -= dl;
#pragma unroll
        for (int dt = 0; dt < 4; ++dt)
#pragma unroll
            for (int r = 0; r < 16; ++r) st.O[dt][r] *= alpha;
    }
    float ps = 0.f;
#pragma unroll
    for (int g = 0; g < 4; ++g) { const int mt = g >> 1, s = g & 1; u32x4 pk;
#pragma unroll
        for (int e = 0; e < 4; ++e) { unsigned w = pk2(fast_exp2(sT[mt][8 * s + 2 * e]), fast_exp2(sT[mt][8 * s + 2 * e + 1]));
            ps = __builtin_amdgcn_fdot2_f32_bf16(__builtin_bit_cast(bf16x2_t, w), __builtin_bit_cast(bf16x2_t, 0x3f803f80u), ps, false);
            pk[e] = w; }
        const bf16x8 B = __builtin_bit_cast(bf16x8, pk);
        __builtin_amdgcn_sched_barrier(0);
        __builtin_amdgcn_s_setprio(2);
        if ((g & 1) == 0) {
#pragma unroll
            for (int dt = 0; dt < 4; ++dt) { vb[dt] = nsa_ldv(L, dt, g + 1, r32, h); st.O[dt] = MFMA32(va[dt], B, st.O[dt]); }
        } else {
#pragma unroll
            for (int dt = 0; dt < 4; ++dt) { if (g < 3) va[dt] = nsa_ldv(L, dt, g + 1, r32, h); st.O[dt] = MFMA32(vb[dt], B, st.O[dt]); }
        }
        __builtin_amdgcn_s_setprio(0);
        __builtin_amdgcn_sched_barrier(0);
    }
    st.l += ps;
}
template <int BR> DI void nsa_branch(NsaState& st, const bf16x8 (&qf)[8], LAS unsigned char* L, const bf16_t* Kg, const bf16_t* Vg, int ldv, int t_lo, int t_hi, int qb, int tq, const u32x4& selw, int tid0) {
#pragma unroll
    for (int dt = 0; dt < 4; ++dt)
#pragma unroll
        for (int r = 0; r < 16; ++r) st.O[dt][r] = 0.f;
    st.m = 0.f; st.l = 0.f;
    NsaTile T;
    { int tid = tid0; asm volatile("" : "+v"(tid)); nsa_tile_load(T, Kg, Vg, ldv, t_lo, tid);
        __syncthreads();
        nsa_tile_store(T, L + (t_lo & 1) * NL_BUF, tid);
        if (t_lo < t_hi) nsa_tile_load(T, Kg, Vg, ldv, t_lo + 1, tid);
        __syncthreads(); }
#pragma unroll 1
    for (int t = t_lo; t <= t_hi; ++t) {
        int tid = tid0; asm volatile("" : "+v"(tid)); const int lane = tid & 63, r32 = lane & 31, h = lane >> 5;
        if (t < t_hi) nsa_tile_store(T, L + ((t + 1) & 1) * NL_BUF, tid);
        if (t + 1 < t_hi) nsa_tile_load(T, Kg, Vg, ldv, t + 2, tid);
        bool lane_sel = true, edge;
        if constexpr (BR == 0) edge = (1024 * t + 1039 > 64 * qb) || (t == 7);
        else if constexpr (BR == 1) { edge = (t == qb); const unsigned wsel = (t < 32) ? selw.x : (t < 64) ? selw.y : (t < 96) ? selw.z : selw.w; lane_sel = (wsel >> (t & 31)) & 1u; }
        else edge = (t == qb) || (t + 8 == qb);
        if (BR != 1 || __any(lane_sel)) nsa_tile_compute<BR>(st, qf, L + (t & 1) * NL_BUF, t, tq, lane_sel, edge, r32, h);
        __syncthreads();
    }
}
DI void nsa_flush_native(const NsaState& st, bf16_t* OWN, int item, float gate, int tid) {
    float lt = half_sum(st.l);
    const float sc = (lt > 0.f) ? gate / lt : 0.f;
    u32x2* base = (u32x2*)OWN + (size_t)item * 16 * 512 + tid;
#pragma unroll
    for (int dt = 0; dt < 4; ++dt)
#pragma unroll
        for (int q = 0; q < 4; ++q) base[(dt * 4 + q) * 512] = (u32x2){pk2(st.O[dt][4 * q] * sc, st.O[dt][4 * q + 1] * sc), pk2(st.O[dt][4 * q + 2] * sc, st.O[dt][4 * q + 3] * sc)};
}
template <int RMW> DI void nsa_flush(const NsaState& st, bf16_t* OW, size_t tok, int head, float gate, int lane) {
    const int h = lane >> 5;
    float lt = half_sum(st.l);
    const float sc = (lt > 0.f) ? gate / lt : 0.f;
#pragma unroll
    for (int dt = 0; dt < 4; ++dt)
#pragma unroll
        for (int q = 0; q < 4; ++q) { bf16_t* p = OW + tok * 1024 + head * 128 + 32 * dt + crow(4 * q, h);
            float o[4];
#pragma unroll
            for (int e = 0; e < 4; ++e) o[e] = st.O[dt][4 * q + e] * sc;
            if constexpr (RMW) { const u32x2 old = *(const u32x2*)p; o[0] += bflo(old.x); o[1] += bfhi(old.x); o[2] += bflo(old.y); o[3] += bfhi(old.y); }
            *(u32x2*)p = (u32x2){pk2(o[0], o[1]), pk2(o[2], o[3])}; }
}
DI void nsa_load_q(bf16x8 (&qf)[8], const bf16_t* NQ, size_t tok, int head, int h) {
#pragma unroll
    for (int s = 0; s < 8; ++s) qf[s] = *(const bf16x8*)(NQ + tok * 1024 + head * 128 + 16 * s + 8 * h);
}
DI void nsa_win_item(const Frame& F, CArgs& a, int item) {
    unsigned char* act = a.ws + WS_ACT; LAS unsigned char* L = F.lds;
    const int qb = item >> 2, bg = item & 3, b = bg >> 1, g = bg & 1;
    const int lane = F.lane, r32 = lane & 31, h = lane >> 5, w = F.wave;
    const int ti = 8 * w + (r32 >> 2), j = r32 & 3, head = g * 4 + j, tq = 64 * qb + ti; const size_t tok = (size_t)b * SEQ + tq;
    bf16x8 qf[8]; nsa_load_q(qf, (const bf16_t*)(act + A0_NQ), tok, head, h);
    NsaState st; const u32x4 nosel = {0u, 0u, 0u, 0u};
    nsa_branch<2>(st, qf, L, (const bf16_t*)(act + A0_NKW) + (size_t)bg * SEQ * 128, (const bf16_t*)(act + A0_NVWT) + (size_t)bg * 128 * SEQ, SEQ, qb >= 8 ? qb - 8 : 0, qb, qb, tq, nosel, F.tid);
    const float gate = ((const float*)(act + A0_NGATE))[tok * 24 + head * 3 + 2];
    nsa_flush_native(st, (bf16_t*)(a.ws + WS_OW), item, gate, F.tid);
}
DI void nsa_main_item(const Frame& F, CArgs& a, int item) {
    unsigned char* act = a.ws + WS_ACT; LAS unsigned char* L = F.lds;
    const int qb = item >> 2, bg = item & 3, b = bg >> 1, g = bg & 1;
    const int lane = F.lane, r32 = lane & 31, h = lane >> 5, w = F.wave;
    const int ti = 8 * w + (r32 >> 2), j = r32 & 3, head = g * 4 + j, tq = 64 * qb + ti; const size_t tok = (size_t)b * SEQ + tq;
    PROF(63);
    bf16x8 qf[8]; nsa_load_q(qf, (const bf16_t*)(act + A0_NQ), tok, head, h);
    const bf16_t* KC = (const bf16_t*)(a.ws + WS_KC) + (size_t)bg * 512 * 128; const bf16_t* VCT = (const bf16_t*)(a.ws + WS_VCT) + (size_t)bg * 128 * 512;
    const float* gates = (const float*)(act + A0_NGATE) + tok * 24 + head * 3;
    NsaState st; const u32x4 nosel = {0u, 0u, 0u, 0u};
    const int tc_hi = (4 * qb + 2) >> 6;
    nsa_branch<0>(st, qf, L, KC, VCT, 512, 0, tc_hi, qb, tq, nosel, F.tid);
    PROF(70);
    nsa_flush_native(st, (bf16_t*)(a.ws + WS_OC), item, gates[0], F.tid);
    LAS float* IMP = (LAS float*)(L + NL_IMP) + w * 2 * 8 * 132;
    LAS unsigned* SEL = (LAS unsigned*)(L + NL_SEL);
    u32x4 selw;
    if (qb >= 16) {
        const float lt = half_sum(st.l); const float mfin = st.m + (lt > 0.f ? __log2f(lt) : 1e30f);
        for (int e = lane; e < 2 * 8 * 132; e += 64) IMP[e] = 0.f;
        u32x4 kt0, kt1;
#define IMP_KLOAD(t_) do { const int c0_ = tidl, c1_ = tidl + 512; kt0 = *(const u32x4*)(KC + (size_t)(64 * (t_) + (c0_ >> 4)) * 128 + (c0_ & 15) * 8); kt1 = *(const u32x4*)(KC + (size_t)(64 * (t_) + (c1_ >> 4)) * 128 + (c1_ & 15) * 8); } while (0)
#define IMP_KSTORE(b_) do { const int c0_ = tidl, c1_ = tidl + 512; LAS unsigned char* lb_ = L + (b_) * NL_BUF; *(LAS u32x4*)(lb_ + NL_K + (c0_ >> 4) * NSA_KP + (c0_ & 15) * 16) = kt0; *(LAS u32x4*)(lb_ + NL_K + (c1_ >> 4) * NSA_KP + (c1_ & 15) * 16) = kt1; } while (0)
        { int tidl = F.tid; asm volatile("" : "+v"(tidl));
            IMP_KLOAD(0);
            __syncthreads();
            IMP_KSTORE(0); if (0 < tc_hi) IMP_KLOAD(1);
            __syncthreads(); }
#pragma unroll 1
        for (int t = 0; t <= tc_hi; ++t) {
            int tidl = F.tid; asm volatile("" : "+v"(tidl)); const int lane = tidl & 63, r32 = lane & 31, h = lane >> 5, j = r32 & 3;
            if (t < tc_hi) IMP_KSTORE((t + 1) & 1);
            if (t + 1 < tc_hi) IMP_KLOAD(t + 2);
            f32x16 sT[2]; nsa_scores(sT, qf, L + (t & 1) * NL_BUF, r32, h);
            const bool full = (t < 7) && (16 * (64 * t + 63) + 31 <= 64 * qb + 8 * w);
            if (!full) {
#pragma unroll
                for (int mt = 0; mt < 2; ++mt)
#pragma unroll
                    for (int r = 0; r < 16; ++r) { const int n = 64 * t + 32 * mt + crow(r, h); const bool ok = (16 * n + 31 <= tq) && (n <= 510); sT[mt][r] = ok ? sT[mt][r] : -1e30f; }
            }
#pragma unroll
            for (int mt = 0; mt < 2; ++mt)
#pragma unroll
                for (int q = 0; q < 4; ++q) { float p[4];
#pragma unroll
                    for (int e = 0; e < 4; ++e) p[e] = fast_exp2(sT[mt][4 * q + e] - mfin);
                    float qs = (p[0] + p[1]) + (p[2] + p[3]), p3 = p[3];
                    qs = quad_sum(qs); p3 = quad_sum(p3);
                    const int ablk = 16 * t + 8 * mt + 2 * q + h;
                    if (j == 0) { IMP[(r32 >> 2) * 132 + ablk] = qs; IMP[8 * 132 + (r32 >> 2) * 132 + ablk + 1] = p3; } }
            __syncthreads();
        }
#undef IMP_KLOAD
#undef IMP_KSTORE
        PROF(71);
        { int tidl = F.tid; asm volatile("" : "+v"(tidl)); const int lane = tidl & 63; const int tl = lane >> 3, sub = lane & 7;
            unsigned key[16];
#pragma unroll
            for (int u = 0; u < 16; ++u) { const int s = 1 + sub + 8 * u; const int sx = (s < 128 ? s : 127); const float v = IMP[tl * 132 + sx] + IMP[8 * 132 + tl * 132 + sx];
                key[u] = (s <= qb - 2) ? ((__float_as_uint(v) & ~127u) | (unsigned)(127 - s)) + 128u : 0u; }
            unsigned pre = 0u; bool done = false;
#pragma unroll 1
            for (int bit = 30; bit >= 0; --bit) { const unsigned trial = pre | (1u << bit); int c = 0;
#pragma unroll
                for (int u = 0; u < 16; ++u) c += (key[u] >= trial) ? 1 : 0;
                c = oct_sum(c);
                if (!done && c >= 13) { pre = trial; done = (c == 13); }
                if (__all(done)) break; }
            unsigned m0 = 0u, m1 = 0u, m2 = 0u, m3 = 0u;
#pragma unroll
            for (int u = 0; u < 16; ++u) { const int s = 1 + sub + 8 * u; if (key[u] >= pre && key[u] != 0u) { const unsigned bitv = 1u << (s & 31);
                    if (s < 32) m0 |= bitv; else if (s < 64) m1 |= bitv; else if (s < 96) m2 |= bitv; else m3 |= bitv; } }
            m0 = oct_or(m0); m1 = oct_or(m1); m2 = oct_or(m2); m3 = oct_or(m3);
            m0 |= 1u;
            { const int s1 = qb, s2 = qb - 1; const unsigned b1 = 1u << (s1 & 31), b2 = 1u << (s2 & 31);
                if (s1 < 32) m0 |= b1; else if (s1 < 64) m1 |= b1; else if (s1 < 96) m2 |= b1; else m3 |= b1;
                if (s2 < 32) m0 |= b2; else if (s2 < 64) m1 |= b2; else if (s2 < 96) m2 |= b2; else m3 |= b2; }
            if (sub == 0) { SEL[(8 * w + tl) * 4 + 0] = m0; SEL[(8 * w + tl) * 4 + 1] = m1; SEL[(8 * w + tl) * 4 + 2] = m2; SEL[(8 * w + tl) * 4 + 3] = m3; }
        }
        __syncthreads();
        PROF(72);
        selw = *(LAS u32x4*)(SEL + ti * 4);
    } else {
        selw = (u32x4){0xffffffffu, 0xffffffffu, 0xffffffffu, 0xffffffffu};
    }
    nsa_branch<1>(st, qf, L, (const bf16_t*)(act + A0_NKS) + (size_t)bg * SEQ * 128, (const bf16_t*)(act + A0_NVST) + (size_t)bg * 128 * SEQ, SEQ, 0, qb, qb, tq, selw, F.tid);
    PROF(73);
    { float lt = half_sum(st.l); const float sc = (lt > 0.f) ? gates[1] / lt : 0.f;
        const u32x2* OWN = (const u32x2*)(a.ws + WS_OW) + (size_t)item * 16 * 512 + F.tid; const u32x2* OCN = (const u32x2*)(a.ws + WS_OC) + (size_t)item * 16 * 512 + F.tid;
        LAS unsigned char* TL = L + (32 * w) * 272;
        const int rl0 = lane >> 4, piece = lane & 15;
        const size_t tokw = (size_t)b * SEQ + 64 * qb + 8 * w;
        u32x4 zv[8];
        __builtin_amdgcn_sched_barrier(0);
#pragma unroll
        for (int i = 0; i < 8; ++i) { const int rl = 4 * i + rl0; zv[i] = *(const u32x4*)((const bf16_t*)(act + A0_NZ) + (tokw + (rl >> 2)) * 1024 + (g * 4 + (rl & 3)) * 128 + piece * 8); }
        u32x2 ow[4][4], oc[4][4];
#pragma unroll
        for (int dt = 0; dt < 4; ++dt)
#pragma unroll
            for (int q = 0; q < 4; ++q) { ow[dt][q] = OWN[(dt * 4 + q) * 512]; oc[dt][q] = OCN[(dt * 4 + q) * 512]; }
        __builtin_amdgcn_sched_barrier(0);
#pragma unroll
        for (int i = 0; i < 8; ++i) { const int rl = 4 * i + rl0; *(LAS u32x4*)(TL + rl * 272 + piece * 16) = zv[i]; }
        asm volatile("s_waitcnt lgkmcnt(0)" ::: "memory");
#pragma unroll
        for (int dt = 0; dt < 4; ++dt)
#pragma unroll
            for (int q = 0; q < 4; ++q) { const int d0 = 32 * dt + crow(4 * q, h); const u32x2 a1 = ow[dt][q], a2 = oc[dt][q]; LAS u32x2* zp = (LAS u32x2*)(TL + r32 * 272 + d0 * 2); const u32x2 z = *zp;
                const float o0 = (st.O[dt][4 * q + 0] * sc + bflo(a1.x) + bflo(a2.x)) * silu_fast(bflo(z.x)), o1 = (st.O[dt][4 * q + 1] * sc + bfhi(a1.x) + bfhi(a2.x)) * silu_fast(bfhi(z.x));
                const float o2 = (st.O[dt][4 * q + 2] * sc + bflo(a1.y) + bflo(a2.y)) * silu_fast(bflo(z.y)), o3 = (st.O[dt][4 * q + 3] * sc + bfhi(a1.y) + bfhi(a2.y)) * silu_fast(bfhi(z.y));
                *zp = (u32x2){pk2(o0, o1), pk2(o2, o3)}; }
        asm volatile("s_waitcnt lgkmcnt(0)" ::: "memory");
#pragma unroll
        for (int i = 0; i < 8; ++i) { const int rl = 4 * i + rl0; const u32x4 v = *(const LAS u32x4*)(TL + rl * 272 + piece * 16);
            *(u32x4*)((bf16_t*)(a.ws + WS_CONCAT) + (tokw + (rl >> 2)) * 2048 + 1024 + (g * 4 + (rl & 3)) * 128 + piece * 8) = v; } }
    __syncthreads();
    PROF(74);
    if (F.bid == PROF_BID && F.tid == 0) ((unsigned long long*)(a.ws + 32768))[75] += 100ull * (unsigned)(qb + 1);
}
DI void nsa_compress_finish_item(const Frame& F, CArgs& a, int it) {
    LAS float* HID = (LAS float*)F.lds;
    LAS float* B1 = (LAS float*)(F.lds + 33024);
    LAS float* RED = (LAS float*)(F.lds + 34048);
    const float* P = (const float*)(a.ws + WS_CONCAT);
    const int job = it >> 6, r0 = (it & 63) * 32;
    __syncthreads();
    if (F.tid < 256) { float s = 0.f;
#pragma unroll 16
        for (int j = 0; j < 64; ++j) s += ((const float*)(a.ws + WS_B1P))[(size_t)(job * 64 + j) * 256 + F.tid];
        B1[F.tid] = s; }
    __syncthreads();
#pragma unroll 4
    for (int e = F.tid; e < 32 * 256; e += NTHR) { const int rr = e >> 8, cidx = e & 255; float s = B1[cidx];
#pragma unroll
        for (int ks = 0; ks < 8; ++ks) s += P[((size_t)(job * 8 + ks) * 2048 + r0 + rr) * 256 + cidx];
        HID[rr * 257 + cidx] = silu_fast(s); }
    __syncthreads();
    { const float* w2 = a.in[job ? 16 : 13];
        const int lane = F.lane, r32 = lane & 31, h = lane >> 5, nt = F.wave & 3, kh = F.wave >> 2;
        const int o = 32 * nt + r32, dsrc = job ? o : dperm(o);
        f32x16 acc;
#pragma unroll
        for (int r = 0; r < 16; ++r) acc[r] = 0.f;
#pragma unroll 1
        for (int s0 = 0; s0 < 64; s0 += 32) { float bv[32];
#pragma unroll
            for (int u = 0; u < 32; ++u) bv[u] = w2[(size_t)(128 * kh + 2 * (s0 + u) + h) * 128 + dsrc];
#pragma unroll
            for (int u = 0; u < 32; ++u) { const float av = HID[r32 * 257 + 128 * kh + 2 * (s0 + u) + h]; acc = __builtin_amdgcn_mfma_f32_32x32x2f32(av, bv[u], acc, 0, 0, 0); } }
        if (kh == 1) {
#pragma unroll
            for (int r = 0; r < 16; ++r) RED[(nt * 16 + r) * 64 + lane] = acc[r]; }
        __syncthreads();
        if (kh == 0) {
#pragma unroll
            for (int r = 0; r < 16; ++r) { const int row = r0 + crow(r, h), bg = row >> 9, n = row & 511; const float sv = (n == 511) ? 0.f : acc[r] + RED[(nt * 16 + r) * 64 + lane];
                if (job == 0) ((bf16_t*)(a.ws + WS_KC))[((size_t)bg * 512 + n) * 128 + o] = (bf16_t)f2bf(sv);
                else ((bf16_t*)(a.ws + WS_VCT))[((size_t)bg * 128 + o) * 512 + n] = (bf16_t)f2bf(sv); } }
    }
    __syncthreads();
}
DI unsigned queue_next(const Frame& F, unsigned* ctr) {
    __syncthreads();
    if (F.tid == 0) *(LAS unsigned*)(F.lds + NL_QI) = __hip_atomic_fetch_add(ctr, 1u, __ATOMIC_RELAXED, __HIP_MEMORY_SCOPE_AGENT);
    __syncthreads();
    return *(LAS unsigned*)(F.lds + NL_QI);
}
__global__ void __launch_bounds__(NTHR, 2) trunk_fwd(Args args_unused) {
    extern __shared__ __attribute__((aligned(16))) unsigned char lds_raw[];
    Frame F;
    F.lds = (LAS unsigned char*)lds_raw;
    F.tid = threadIdx.x; F.lane = F.tid & 63; F.wave = __builtin_amdgcn_readfirstlane(F.tid >> 6);
    F.G = gridDim.x; F.bid = blockIdx.x;
    volatile LAS unsigned* MISC = (volatile LAS unsigned*)(F.lds + MISC_OFF);
    CArgs* ap0 = (CArgs*)__builtin_amdgcn_kernarg_segment_ptr();
    unsigned* ctl = (unsigned*)(ap0->ws + WS_CTL);
    for (int u = F.tid; u < (LDS_BYTES - LDSCTL_OFF) / 4; u += NTHR) ((LAS unsigned*)(F.lds + LDSCTL_OFF))[u] = 0u;
    __syncthreads();
    XcdBarrier bar = xcd_barrier_post(ctl + CW_BAR, MISC + 8);
#if PROF_BID >= 0
    prof_lap(F.lds, ap0->ws, 99);
#endif
    const int lo = ap0->ph_lo, hi = ap0->ph_hi; int pcount_ = 0; (void)pcount_;
#ifdef ONLY
#define IN(k) ((k) == ONLY && lo <= (k) && (k) < hi)
#else
#define IN(k) (lo <= (k) && (k) < hi)
#endif
#if PROF_BID >= 0
#define GRID_BAR() do { xcd_barrier(bar); prof_lap(F.lds, ws, 100 + (pcount_++)); } while (0)
#else
#define GRID_BAR() xcd_barrier(bar)
#endif
#ifndef PROBE_DUP
#define PROBE_DUP -1
#endif
#define REP(k) for (int rep_ = 0; rep_ < ((k) == PROBE_DUP ? 2 : 1); ++rep_)
#define PHASE_ARGS() CArgs* ap = ap0; asm volatile("" : "+s"(ap)); CArgs& args = *ap; unsigned char* ws = args.ws; (void)ws
    if (IN(0)) REP(0) { PHASE_ARGS(); p0_prologue(F, args); GRID_BAR(); }
    if (IN(1)) REP(1) { PHASE_ARGS(); p1_prenorm0(F, args); p0_weights(F, args, 0, F.bid * NWAVES + F.wave, F.G * NWAVES); GRID_BAR(); }
    if (IN(2)) REP(2) { PHASE_ARGS();
        pg8::Gemm g; g.A[0] = (const bf16_t*)(ws + WS_HY); g.Bt[0] = (const bf16_t*)(ws + WS_WN0); g.nM[0] = MTOK / 256; g.nN[0] = NN0 / 256; g.nK[0] = 1;
        g.A[1] = (const bf16_t*)(ws + WS_WT0); g.Bt[1] = (const bf16_t*)(ws + WS_HY); g.nM[1] = NT0 / 256; g.nN[1] = MTOK / 256; g.nK[1] = 1; g.lda = DM; g.ldb = DM; g.Klen = DM; g.chain = 0;
        pg8::MultiOrder S; S.init(g, F.G, F.bid); EpiProj<0> E{ws};
        pg8::gemm_phase<EpiProj<0>>(F.lds, g, S, E);
        { const int ntile = (MTOK / 256) * (NN0 / 256) + (NT0 / 256) * (MTOK / 256), nfull = ntile % F.G;
          if (nfull > 0 && F.bid >= nfull) p0_weights(F, args, 1, (F.bid - nfull) * NWAVES + F.wave, (F.G - nfull) * NWAVES);
          else if (nfull == 0) p0_weights(F, args, 1, F.bid * NWAVES + F.wave, F.G * NWAVES); }
        GRID_BAR();
    }
    if (IN(3)) REP(3) { PHASE_ARGS();
        const int half = F.G / 2;
        if (F.bid >= half) {
            pg8::Gemm g; g.A[0] = (const bf16_t*)(ws + WS_ACT + A0_NKC); g.Bt[0] = (const bf16_t*)(ws + WS_W1K); g.nM[0] = 8; g.nN[0] = 1; g.nK[0] = 8;
            g.A[1] = (const bf16_t*)(ws + WS_ACT + A0_NVC); g.Bt[1] = (const bf16_t*)(ws + WS_W1V); g.nM[1] = 8; g.nN[1] = 1; g.nK[1] = 8; g.lda = 2048; g.ldb = 4096; g.Klen = 512; g.chain = 0;
            pg8::MultiOrder S; S.init(g, F.G - half, F.bid - half); EpiF32Part E{(float*)(ws + WS_CONCAT)};
            pg8::gemm_phase<EpiF32Part>(F.lds, g, S, E);
        }
        unsigned* qctr = (unsigned*)(ws + WS_CTL) + 2048 + 128 + 64 * rep_;
        for (;;) { const unsigned idx = queue_next(F, qctr); if (idx >= 1024u) break; la_prep<0>(F, args, (int)idx); }
        GRID_BAR();
    }
    if (IN(4)) REP(4) { PHASE_ARGS();
        const int half = F.G / 2;
        if (F.bid < half) la_phase<0, 0>(F, args, F.bid, half);
        else for (int it = F.bid - half; it < 128; it += F.G - half) nsa_compress_finish_item(F, args, it);
        unsigned* qctr = (unsigned*)(ws + WS_CTL) + 2048 + 256 + 64 * rep_;
        for (;;) { const unsigned idx = queue_next(F, qctr); if (idx >= 512u) break; nsa_win_item(F, args, 511 - (int)idx); }
        GRID_BAR();
    }
    if (IN(5)) REP(5) { PHASE_ARGS();
        const int half = F.G / 2;
        for (int r2 = 0; r2 < (PROBE_DUP == 50 ? 2 : 1); ++r2) if (F.bid < half) la_phase<0, 1>(F, args, F.bid, half);
        for (int r2 = 0; r2 < (PROBE_DUP == 51 ? 2 : 1); ++r2) {
        unsigned* qctr = (unsigned*)(ws + WS_CTL) + 2048 + 64 * rep_ + 512 * r2;
        for (;;) { const unsigned idx = queue_next(F, qctr); if (idx >= 512u) break; nsa_main_item(F, args, (127 - (int)(idx >> 2)) * 4 + (int)(idx & 3u)); }
        }
        GRID_BAR();
    }
    if (IN(6)) REP(6) { PHASE_ARGS();
        pg8::Gemm g; g.A[0] = (const bf16_t*)(ws + WS_CONCAT); g.Bt[0] = (const bf16_t*)(ws + WS_WO0); g.nM[0] = MTOK / 256; g.nN[0] = DM / 256; g.nK[0] = 1;
        g.A[1] = nullptr; g.Bt[1] = nullptr; g.nM[1] = 0; g.nN[1] = 0; g.nK[1] = 1; g.lda = DM; g.ldb = DM; g.Klen = DM; g.chain = 0;
        pg8::MultiOrder S; S.init(g, F.G, F.bid); EpiBf16 E{(bf16_t*)(ws + WS_HY), DM};
        pg8::gemm_phase<EpiBf16>(F.lds, g, S, E);
        GRID_BAR();
    }
    if (IN(7)) REP(7) { PHASE_ARGS(); p_residual<0>(F, args); GRID_BAR(); }
    if (IN(8)) REP(8) { PHASE_ARGS();
        pg8::Gemm g; g.A[0] = (const bf16_t*)(ws + WS_HY); g.Bt[0] = (const bf16_t*)(ws + WS_WN1); g.nM[0] = MTOK / 256; g.nN[0] = NN1 / 256; g.nK[0] = 1;
        g.A[1] = (const bf16_t*)(ws + WS_WT1); g.Bt[1] = (const bf16_t*)(ws + WS_HY); g.nM[1] = NT1 / 256; g.nN[1] = MTOK / 256; g.nK[1] = 1; g.lda = DM; g.ldb = DM; g.Klen = DM; g.chain = 0;
        pg8::MultiOrder S; S.init(g, F.G, F.bid); EpiProj<1> E{ws};
        pg8::gemm_phase<EpiProj<1>>(F.lds, g, S, E);
        { const int ntile = (MTOK / 256) * (NN1 / 256) + (NT1 / 256) * (MTOK / 256), nfull = ntile % F.G;
          if (nfull > 0 && F.bid >= nfull) p0_weights(F, args, 2, (F.bid - nfull) * NWAVES + F.wave, (F.G - nfull) * NWAVES);
          else if (nfull == 0) p0_weights(F, args, 2, F.bid * NWAVES + F.wave, F.G * NWAVES); }
        GRID_BAR();
    }
    if (IN(9)) REP(9) { PHASE_ARGS();
        ssd_prep(F, args);
        hgrn_prep_cols(F, args);
        GRID_BAR();
    }
    if (IN(10)) REP(10) { PHASE_ARGS();
        const int half = F.G / 2;
        if (F.bid < half) la_phase<1, 0>(F, args, F.bid, half); else la_phase<2, 0>(F, args, F.bid - half, F.G - half);
        GRID_BAR();
    }
    if (IN(11)) REP(11) { PHASE_ARGS();
        for (int it = F.bid; it < 128; it += F.G) { const int m = it >> 6, bh = (it >> 3) & 7, wsl = it & 7; if (m == 0) la_scan_item<1>(F, args, bh, wsl); else la_scan_item<2>(F, args, bh, wsl); }
        GRID_BAR();
    }
    if (IN(12)) REP(12) { PHASE_ARGS();
        const int half = F.G / 2;
#if !defined(SKIP_H)
        if (F.bid < half) la_phase<1, 1, true>(F, args, F.bid, half);
#endif
#if !defined(SKIP_S)
        if (F.bid >= half) la_phase<2, 1, true>(F, args, F.bid - half, F.G - half);
#endif
        GRID_BAR();
    }
    if (IN(13)) REP(13) { PHASE_ARGS();
        pg8::Gemm g; g.A[0] = (const bf16_t*)(ws + WS_CONCAT); g.Bt[0] = (const bf16_t*)(ws + WS_WO1); g.nM[0] = MTOK / 256; g.nN[0] = DM / 256; g.nK[0] = 2;
        g.A[1] = nullptr; g.Bt[1] = nullptr; g.nM[1] = 0; g.nN[1] = 0; g.nK[1] = 1; g.lda = DM; g.ldb = DM; g.Klen = DM / 2; g.chain = 1;
        pg8::MultiOrder S; S.init(g, F.G, F.bid); EpiBf16Mid E{(bf16_t*)(ws + WS_HY), DM, (const float*)(ws + WS_RTAB)};
        { pg8::Unit u; for (int i = 0; S.next(i, u); ++i) if (F.tid < 256) { const int row = u.pm * 256 + F.tid; const f32x4* p = (const f32x4*)((const float*)(ws + WS_SSQ) + (size_t)row * 16);
                const f32x4 q0 = p[0], q1 = p[1], q2 = p[2], q3 = p[3];
                const float s = ((q0[0] + q0[1]) + (q0[2] + q0[3])) + ((q1[0] + q1[1]) + (q1[2] + q1[3])) + ((q2[0] + q2[1]) + (q2[2] + q2[3])) + ((q3[0] + q3[1]) + (q3[2] + q3[3]));
                ((float*)(ws + WS_RTAB))[row] = 1.0f / sqrtf(s * (1.0f / 1024.0f) + EPS); }
          asm volatile("s_waitcnt vmcnt(0)" ::: "memory"); __syncthreads(); }
        pg8::gemm_phase<EpiBf16Mid>(F.lds, g, S, E);
        GRID_BAR();
    }
    if (IN(14)) REP(14) { PHASE_ARGS(); p_residual<1>(F, args);
#if PROF_BID >= 0
        __syncthreads(); prof_lap(F.lds, ws, 114);
        if (F.bid == 0 && F.tid == 0) { const unsigned long long* ts = (const unsigned long long*)(ws + 32768);
#ifdef PROF_CAL
            args.out[0] = 1000.f * 500.f; args.out[1] = 1000.f * 250.f;
#else
            args.out[0] += (float)ts[PROF_A] * 0.01f * PROF_SCALE; args.out[1] += (float)ts[PROF_B] * 0.01f * PROF_SCALE;
#endif
        }
#endif
    }
#undef IN
#undef GRID_BAR
}

extern "C" void kernel_launch(void* const* d_in, const int* in_sizes, int n_in, void* d_out, int out_size, void* d_ws, size_t ws_size, hipStream_t stream) {
    static int grid = 0;
    if (grid == 0) {
        if (n_in != 27 || out_size != MTOK * DM || ws_size < WS_END) { fprintf(stderr, "kernel_launch: unexpected shapes (n_in %d, out %d, ws %zu < %zu)\n", n_in, out_size, ws_size, (size_t)WS_END); grid = -1; return; }
        int dev = 0, cus = 0;
        if (hipGetDevice(&dev) != hipSuccess || hipDeviceGetAttribute(&cus, hipDeviceAttributeMultiprocessorCount, dev) != hipSuccess) { grid = -1; return; }
        if (hipFuncSetAttribute((const void*)trunk_fwd, hipFuncAttributeMaxDynamicSharedMemorySize, LDS_BYTES) != hipSuccess) { fprintf(stderr, "kernel_launch: hipFuncSetAttribute failed\n"); grid = -1; return; }
        (void)hipGetLastError();
        grid = cus;
    }
    if (grid < 0) return;
    if (hipMemsetAsync((char*)d_ws + WS_CTL, 0, CTL_ZERO_BYTES, stream) != hipSuccess) return;
    Args a{};
    for (int i = 0; i < 27; ++i) a.in[i] = (const float*)d_in[i];
    a.out = (float*)d_out; a.ws = (unsigned char*)d_ws; a.ph_lo = 0; a.ph_hi = 15;
    hipLaunchKernelGGL(trunk_fwd, dim3(grid), dim3(NTHR), LDS_BYTES, stream, a);
}
```

```cpp
#include <hip/hip_runtime.h>
#include <cstdio>
#include <cstdint>

#define GAS __attribute__((address_space(1)))
#define LAS __attribute__((address_space(3)))
#define DI __device__ __forceinline__
typedef unsigned short bf16_t;
typedef short bf16x8 __attribute__((ext_vector_type(8)));
typedef short s16x4 __attribute__((ext_vector_type(4)));
typedef float f32x2 __attribute__((ext_vector_type(2)));
typedef float f32x4 __attribute__((ext_vector_type(4)));
typedef float f32x16 __attribute__((ext_vector_type(16)));
typedef unsigned u32x2 __attribute__((ext_vector_type(2)));
typedef unsigned u32x4 __attribute__((ext_vector_type(4)));
typedef __bf16 bf16x2_t __attribute__((ext_vector_type(2)));

DI unsigned f2bf(float f) { unsigned u = __builtin_bit_cast(unsigned, f); return (u + 0x7fffu + ((u >> 16) & 1u)) >> 16; }
DI float bf2f(unsigned short h) { return __builtin_bit_cast(float, (unsigned)h << 16); }
DI unsigned pk2(float lo, float hi) { f32x2 v = {lo, hi}; bf16x2_t b = __builtin_convertvector(v, bf16x2_t); return __builtin_bit_cast(unsigned, b); }
DI int dpp_i(int v, int ctrl_sel) { return ctrl_sel == 0 ? __builtin_amdgcn_update_dpp(0, v, 0xB1, 0xf, 0xf, true) : ctrl_sel == 1 ? __builtin_amdgcn_update_dpp(0, v, 0x4E, 0xf, 0xf, true) : __builtin_amdgcn_update_dpp(0, v, 0x141, 0xf, 0xf, true); }
DI float quad_sum(float v) {
    v += __builtin_bit_cast(float, __builtin_amdgcn_update_dpp(0, __builtin_bit_cast(int, v), 0xB1, 0xf, 0xf, true));
    v += __builtin_bit_cast(float, __builtin_amdgcn_update_dpp(0, __builtin_bit_cast(int, v), 0x4E, 0xf, 0xf, true));
    return v; }
DI int oct_sum(int v) {
    v += __builtin_amdgcn_update_dpp(0, v, 0xB1, 0xf, 0xf, true); v += __builtin_amdgcn_update_dpp(0, v, 0x4E, 0xf, 0xf, true); v += __builtin_amdgcn_update_dpp(0, v, 0x141, 0xf, 0xf, true);
    return v; }
DI unsigned oct_or(unsigned v) {
    v |= (unsigned)__builtin_amdgcn_update_dpp(0, (int)v, 0xB1, 0xf, 0xf, true); v |= (unsigned)__builtin_amdgcn_update_dpp(0, (int)v, 0x4E, 0xf, 0xf, true); v |= (unsigned)__builtin_amdgcn_update_dpp(0, (int)v, 0x141, 0xf, 0xf, true);
    return v; }
DI float half_sum(float v) { return v + __shfl_xor(v, 32); }
DI float half_max(float v) { return fmaxf(v, __shfl_xor(v, 32)); }
DI float bflo(unsigned w) { return __builtin_bit_cast(float, w << 16); }
DI float bfhi(unsigned w) { return __builtin_bit_cast(float, w & 0xffff0000u); }
DI float fast_exp2(float x) { return __builtin_amdgcn_exp2f(x); }
DI float sigmoidf_(float x) { return 1.f / (1.f + __expf(-x)); }
DI float siluf_(float x) { return x / (1.f + __expf(-x)); }
DI int crow(int reg, int h) { return (reg & 3) + 8 * (reg >> 2) + 4 * h; }
#define MFMA32(a, b, c) __builtin_amdgcn_mfma_f32_32x32x16_bf16((a), (b), (c), 0, 0, 0)

constexpr int BATCH = 2, SEQ = 8192, DM = 2048, MTOK = BATCH * SEQ;
constexpr int N_EVEN = 6696, N_ODD = 6672;
constexpr float EPS = 1e-6f;
constexpr float LOG2E = 1.4426950408889634f;

namespace pg8 {
constexpr int BM = 256, BK = 64, HALF = 128, HTB = HALF * BK * 2, STAGE_BYTES = 8 * HTB, NXCD = 8, WGM = 8;
__host__ __device__ __forceinline__ int lds_byte(int r, int c) { const int st = (r >> 4) * 2 + (c >> 5), rr = r & 15, cc = c & 31, ob = rr * 64 + cc * 2; return st * 1024 + (ob ^ (((ob >> 9) & 1) << 5)); }
__host__ __device__ __forceinline__ void stage_rc(int b, int& R, int& C) { const int st = b / 1024, sb = b % 1024, swz = sb ^ (((sb >> 9) & 1) << 5); R = (st >> 1) * 16 + swz / 64; C = (st & 1) * 32 + (swz % 64) / 2; }
__host__ __device__ __forceinline__ int perm32(int rho) { const int n = rho >> 4, i = rho & 15; return 8 * (i >> 2) + 4 * n + (i & 3); }

struct Unit { int pm, pn, job, ks; };
struct Gemm { const bf16_t* A[2]; const bf16_t* Bt[2]; int nM[2], nN[2], nK[2]; int lda, ldb, Klen; int chain; };

struct MultiOrder {
    int n0, n1, G, c; int nM0, nN0, nK0, nM1, nN1, nK1, chain;
    __device__ __forceinline__ void init(const Gemm& g, int G_, int c_) { nM0 = g.nM[0]; nN0 = g.nN[0]; nK0 = g.nK[0]; nM1 = g.nM[1]; nN1 = g.nN[1]; nK1 = g.nK[1]; n0 = nM0 * nN0 * nK0; n1 = nM1 * nN1 * nK1; G = G_; c = c_; chain = g.chain; }
    __device__ __forceinline__ static void tile(int wgid, int nM, int nN, int nK, Unit& u) {
        if (nK > 1) { u.ks = wgid % nK; wgid /= nK; u.pn = wgid % nN; u.pm = wgid / nN; return; }
        u.ks = 0; const int nwg = nM * nN;
        { const int q = nwg / NXCD, r = nwg % NXCD, xcd = wgid % NXCD, off = wgid / NXCD; wgid = (xcd < r ? xcd * (q + 1) : r * (q + 1) + (xcd - r) * q) + off; }
        const int nig = WGM * nN, gid = wgid / nig, fm = gid * WGM, gsz = (nM - fm) < WGM ? (nM - fm) : WGM;
        u.pm = fm + ((wgid % nig) % gsz); u.pn = (wgid % nig) / gsz;
    }
    __device__ __forceinline__ bool next(int i, Unit& u) const {
        if (chain) { const long T = (long)(i / nK0) * G + c; if (T >= nM0 * nN0) return false; u.job = 0; tile((int)T, nM0, nN0, 1, u); u.ks = i % nK0; return true; }
        const long L = (long)i * G + c; if (L >= n0 + n1) return false;
        if (L < n0) { u.job = 0; tile((int)L, nM0, nN0, nK0, u); } else { u.job = 1; tile((int)L - n0, nM1, nN1, nK1, u); }
        return true;
    }
};

template <class Epi>
__device__ __forceinline__ void gemm_phase(LAS unsigned char* lds, const Gemm& g, const MultiOrder& S, const Epi& E) {
    static_assert(Epi::PERM, "this copy keeps only the PERM = true staging");
    const int tid = threadIdx.x, wid = __builtin_amdgcn_readfirstlane(tid >> 6), lane = tid & 63, wr = wid >> 2, wc = wid & 3, fr = lane & 15, fq = lane >> 4;
    const int nt = g.Klen / BK;
    unsigned voffA[2], voffB[2];
#pragma unroll
    for (int i = 0; i < 2; ++i) { int R, C; stage_rc(tid * 16 + i * 8192, R, C); const int Rb = (R & ~31) + perm32(R & 31);
        voffA[i] = (unsigned)(R * g.lda + C) * 2u; voffB[i] = (unsigned)(Rb * g.ldb + C) * 2u; }
    const size_t kstep = (size_t)(BK * 2);
    const size_t hstepA = (size_t)HALF * g.lda * 2, hstepB = (size_t)HALF * g.ldb * 2;
    const unsigned ldsw = (unsigned)wid * 1024u;
    const int aoff = lds_byte(wr * 64 + fr, fq * 8), boff = lds_byte(wc * 32 + fr, fq * 8);
#define PG8_SA(b, h) (((b) * 2 + (h)) * HTB)
#define PG8_SB(b, h) ((4 + (b) * 2 + (h)) * HTB)
#define PG8_STAGE(bufoff, gbase, voff) do { _Pragma("unroll") for (int _i = 0; _i < 2; ++_i) \
        __builtin_amdgcn_global_load_lds((const unsigned*)((const char*)(gbase) + (voff)[_i]), (LAS unsigned*)(lds + (bufoff) + ldsw + _i * 8192), 16, 0, 0); } while (0)
#define PG8_LDA(dst, b, h) do { _Pragma("unroll") for (int m = 0; m < 4; ++m) _Pragma("unroll") for (int k = 0; k < 2; ++k) dst[m][k] = *(const LAS bf16x8*)(lds + PG8_SA(b, h) + aoff + m * 2048 + k * 1024); } while (0)
#define PG8_LDB(dst, b, h) do { _Pragma("unroll") for (int n = 0; n < 2; ++n) _Pragma("unroll") for (int k = 0; k < 2; ++k) dst[n][k] = *(const LAS bf16x8*)(lds + PG8_SB(b, h) + boff + n * 2048 + k * 1024); } while (0)
#define PG8_MMA(ai, bj, At, Bt) do { __builtin_amdgcn_s_setprio(1); _Pragma("unroll") for (int m = 0; m < 4; ++m) _Pragma("unroll") for (int n = 0; n < 2; ++n) _Pragma("unroll") for (int k = 0; k < 2; ++k) \
        acc[ai][bj][m][n] = __builtin_amdgcn_mfma_f32_16x16x32_bf16(Bt[n][k], At[m][k], acc[ai][bj][m][n], 0, 0, 0); __builtin_amdgcn_s_setprio(0); } while (0)
#define PG8_WAIT_V(n) asm volatile("s_waitcnt vmcnt(" #n ")" ::: "memory")
#define PG8_WAIT_L(n) asm volatile("s_waitcnt lgkmcnt(" #n ")" ::: "memory")
#define PG8_BAR __builtin_amdgcn_s_barrier()
#define PG8_SCHED __builtin_amdgcn_sched_barrier(0)
#define PG8_UA(u) ((const char*)((u).job ? g.A[1] : g.A[0]) + ((size_t)(u).pm * BM * g.lda + (size_t)(u).ks * g.Klen) * 2)
#define PG8_UB(u) ((const char*)((u).job ? g.Bt[1] : g.Bt[0]) + ((size_t)(u).pn * BM * g.ldb + (size_t)(u).ks * g.Klen) * 2)
    Unit cur, nxt; int ui = 0;
    if (!S.next(0, cur)) return;
    f32x4 acc[2][2][4][2];
#pragma unroll
    for (int a = 0; a < 2; ++a)
#pragma unroll
        for (int b = 0; b < 2; ++b)
#pragma unroll
            for (int m = 0; m < 4; ++m)
#pragma unroll
                for (int n = 0; n < 2; ++n) acc[a][b][m][n] = (f32x4){0.f, 0.f, 0.f, 0.f};
    bf16x8 At[4][2], B0[2][2], B1[2][2];
    const char* cA = PG8_UA(cur); const char* cB = PG8_UB(cur);
    PG8_STAGE(PG8_SB(0, 0), cB, voffB); PG8_STAGE(PG8_SB(0, 1), cB + hstepB, voffB); PG8_STAGE(PG8_SA(0, 0), cA, voffA); PG8_STAGE(PG8_SA(0, 1), cA + hstepA, voffA);
    if (wr == 1) PG8_BAR;
    PG8_WAIT_V(2); PG8_BAR;
    PG8_STAGE(PG8_SB(1, 0), cB + kstep, voffB); PG8_STAGE(PG8_SA(1, 0), cA + kstep, voffA); PG8_STAGE(PG8_SB(1, 1), cB + hstepB + kstep, voffB);
    PG8_WAIT_V(6); PG8_BAR;
    for (;;) {
        const bool has_next = S.next(ui + 1, nxt);
        const char* nA = has_next ? PG8_UA(nxt) : cA; const char* nB = has_next ? PG8_UB(nxt) : cB;
        for (int t = 0; t < nt; t += 2) {
            const bool last = (t == nt - 2);
            const char* a1 = cA + (size_t)(t + 1) * kstep;
            const char* a2 = last ? nA : cA + (size_t)(t + 2) * kstep; const char* b2 = last ? nB : cB + (size_t)(t + 2) * kstep;
            const char* a3 = a2 + kstep; const char* b3 = b2 + kstep;
            PG8_LDB(B0, 0, 0); PG8_LDB(B1, 0, 1); PG8_SCHED; PG8_LDA(At, 0, 0); PG8_STAGE(PG8_SA(1, 1), a1 + hstepA, voffA);
            PG8_WAIT_V(8); PG8_WAIT_L(0); PG8_BAR; PG8_MMA(0, 0, At, B0); PG8_MMA(0, 1, At, B1); PG8_BAR; PG8_SCHED;
            PG8_LDA(At, 0, 1); PG8_STAGE(PG8_SB(0, 0), b2, voffB); PG8_STAGE(PG8_SB(0, 1), b2 + hstepB, voffB); PG8_STAGE(PG8_SA(0, 0), a2, voffA);
            PG8_WAIT_V(8); PG8_WAIT_L(0); PG8_BAR; PG8_MMA(1, 0, At, B0); PG8_MMA(1, 1, At, B1); PG8_BAR; PG8_SCHED;
            PG8_LDB(B0, 1, 0); PG8_LDB(B1, 1, 1); PG8_SCHED; PG8_LDA(At, 1, 0); PG8_STAGE(PG8_SA(0, 1), a2 + hstepA, voffA);
            PG8_WAIT_V(8); PG8_WAIT_L(0); PG8_BAR; PG8_MMA(0, 0, At, B0); PG8_MMA(0, 1, At, B1); PG8_BAR; PG8_SCHED;
            PG8_LDA(At, 1, 1); PG8_STAGE(PG8_SB(1, 0), b3, voffB); PG8_STAGE(PG8_SB(1, 1), b3 + hstepB, voffB); PG8_STAGE(PG8_SA(1, 0), a3, voffA);
            PG8_WAIT_V(8); PG8_WAIT_L(0); PG8_BAR; PG8_MMA(1, 0, At, B0); PG8_MMA(1, 1, At, B1); PG8_BAR; PG8_SCHED;
        }
        if (wr == 0) PG8_BAR;
        const bool keep = E(acc, cur, wr, wc, fr, fq);
        if (!has_next) break;
        if (!keep) {
#pragma unroll
            for (int a = 0; a < 2; ++a)
#pragma unroll
                for (int b = 0; b < 2; ++b)
#pragma unroll
                    for (int m = 0; m < 4; ++m)
#pragma unroll
                        for (int n = 0; n < 2; ++n) acc[a][b][m][n] = (f32x4){0.f, 0.f, 0.f, 0.f};
        }
        cur = nxt; cA = nA; cB = nB; ++ui;
        if (wr == 1) PG8_BAR;
    }
    PG8_WAIT_V(0);
    PG8_BAR;
#undef PG8_SA
#undef PG8_SB
#undef PG8_STAGE
#undef PG8_LDA
#undef PG8_LDB
#undef PG8_MMA
#undef PG8_WAIT_V
#undef PG8_WAIT_L
#undef PG8_BAR
#undef PG8_SCHED
#undef PG8_UA
#undef PG8_UB
}
}
#define XB_TMO      128
#define XB_XCNT(j)  (256  + 64 * (j))
#define XB_XSUB(j)  (1280 + 64 * (j))
#define XB_XGEN(j)  (2304 + 64 * (j))
#define XB_TOP      3328
#define XB_TOPGEN   3392
#define XCD_BAR_WORDS 3456
#define XB_SPIN_CAP (1u << 24)
DI unsigned xb_ld(unsigned* p)              { return __hip_atomic_load(p, __ATOMIC_RELAXED, __HIP_MEMORY_SCOPE_AGENT); }
DI unsigned xb_add(unsigned* p, unsigned v) { return __hip_atomic_fetch_add(p, v, __ATOMIC_RELAXED, __HIP_MEMORY_SCOPE_AGENT); }
DI unsigned xb_xcc_id() { return (unsigned)__builtin_amdgcn_s_getreg((3 << 11) | 20) & 0xFu; }
#define XB_SPIN(cond, bar) do { unsigned _sp = 0; while (cond) { __builtin_amdgcn_s_sleep(1); \
    if ((++_sp & 255u) == 0u) { if (xb_ld(&(bar)[XB_TMO])) break; if (_sp > XB_SPIN_CAP) { atomicAdd(&(bar)[XB_TMO], 1u); break; } } } } while (0)
struct XcdBarrier { unsigned* bar; unsigned x; volatile LAS unsigned* st; };
DI XcdBarrier xcd_barrier_post(unsigned* bar, volatile LAS unsigned* st) {
    XcdBarrier b; b.bar = bar; b.x = xb_xcc_id(); b.st = st;
    if (threadIdx.x == 0) (void)xb_add(&bar[XB_XCNT(b.x)], 1u);
    return b;
}
DI void xcd_barrier_complete(unsigned* bar, unsigned x, unsigned& nloc, unsigned& nx) {
    const unsigned G = gridDim.x * gridDim.y * gridDim.z;
    unsigned sum, cnt, mine, sp = 0u;
    for (;;) {
        sum = 0u; cnt = 0u; mine = 0u;
#pragma unroll
        for (unsigned j = 0; j < 16; ++j) { const unsigned c = xb_ld(&bar[XB_XCNT(j)]); sum += c; cnt += (c > 0u) ? 1u : 0u; mine = (j == x) ? c : mine; }
        if (sum == G) break;
        __builtin_amdgcn_s_sleep(1);
        if ((++sp & 255u) == 0u) { if (xb_ld(&bar[XB_TMO])) break; if (sp > XB_SPIN_CAP) { atomicAdd(&bar[XB_TMO], 1u); break; } }
    }
    nloc = mine > 0u ? mine : 1u; nx = cnt > 0u ? cnt : 1u;
}
DI void xcd_barrier(const XcdBarrier& b) {
    asm volatile("s_waitcnt vmcnt(0)" ::: "memory");
    __syncthreads();
    if (threadIdx.x == 0) {
        unsigned* bar = b.bar;
        __builtin_amdgcn_s_waitcnt(0);
        unsigned nloc = b.st[0], nx = b.st[1];
        if (nloc == 0u) { xcd_barrier_complete(bar, b.x, nloc, nx); b.st[0] = nloc; b.st[1] = nx; }
        const unsigned old = xb_add(&bar[XB_XSUB(b.x)], 1u);
        const unsigned gen = old / nloc;
        if (old + 1u == (gen + 1u) * nloc) {
            __builtin_amdgcn_fence(__ATOMIC_RELEASE, "agent");
            asm volatile("s_waitcnt vmcnt(0)" ::: "memory");
            const unsigned og = xb_add(&bar[XB_TOP], 1u);
            const unsigned tg = og / nx;
            if (og + 1u == (tg + 1u) * nx) xb_add(&bar[XB_TOPGEN], 1u);
            else XB_SPIN(xb_ld(&bar[XB_TOPGEN]) == tg, bar);
            __builtin_amdgcn_fence(__ATOMIC_ACQUIRE, "agent");
            xb_add(&bar[XB_XGEN(b.x)], 1u);
            asm volatile("s_waitcnt vmcnt(0)" ::: "memory");
        } else {
            XB_SPIN(xb_ld(&bar[XB_XGEN(b.x)]) == gen, bar);
            __builtin_amdgcn_fence(__ATOMIC_ACQUIRE, "agent");
            asm volatile("s_waitcnt vmcnt(0)" ::: "memory");
        }
    }
    __syncthreads();
}

constexpr size_t MiB = 1u << 20;
constexpr size_t WS_CTL = 0, CTL_ZERO_BYTES = 64 * 1024;
constexpr int NN0 = 5376, NT0 = 1536, NN1 = 4864, NT1 = 2048;
constexpr size_t WS_WN0 = 1 * MiB;
constexpr size_t WS_WT0 = WS_WN0 + (size_t)NN0 * DM * 2;
constexpr size_t WS_WO0 = WS_WT0 + (size_t)NT0 * DM * 2;
constexpr size_t WS_W1K = WS_WO0 + (size_t)DM * DM * 2;
constexpr size_t WS_W1V = WS_W1K + (size_t)256 * 4096 * 2;
constexpr size_t WS_WN1 = WS_W1V + (size_t)256 * 4096 * 2;
constexpr size_t WS_WT1 = WS_WN1 + (size_t)NN1 * DM * 2;
constexpr size_t WS_WO1 = WS_WT1 + (size_t)NT1 * DM * 2;
constexpr size_t WS_WEND = WS_WO1 + (size_t)DM * DM * 2;
constexpr size_t WS_BL   = 75 * MiB;
static_assert(WS_WEND <= WS_BL && WS_BL + 2 * MiB <= 78 * MiB, "weights");
constexpr size_t WS_SMALL = 78 * MiB;
constexpr size_t WS_MOD   = WS_SMALL;
constexpr size_t WS_ROPE  = WS_SMALL + 1 * MiB;
constexpr size_t WS_LB    = WS_SMALL + 5 * MiB;
constexpr size_t WS_B1P   = WS_LB + 4096;
constexpr size_t WS_KC    = WS_SMALL + 6 * MiB;
constexpr size_t WS_VCT   = WS_KC + 512 * 1024;
constexpr size_t WS_SSQ   = WS_SMALL + 7 * MiB;
constexpr size_t WS_RTAB  = WS_SMALL + 7 * MiB + 512 * 1024 * 2;
constexpr size_t WS_LOGD  = WS_SMALL + 8 * MiB;
constexpr size_t WS_HY    = 88 * MiB;
constexpr size_t WS_ACT   = 152 * MiB;
constexpr size_t WS_CONCAT= 368 * MiB;
constexpr size_t WS_OW    = 432 * MiB;
constexpr size_t WS_U0    = 464 * MiB;
constexpr size_t WS_OC    = 480 * MiB;
constexpr size_t WS_END   = 512 * MiB;
constexpr size_t A0_GQ = 0, A0_GK = 16 * MiB, A0_GZ = 32 * MiB, A0_GVT = 64 * MiB, A0_NQ = 96 * MiB, A0_NZ = 128 * MiB;
constexpr size_t A0_NKC = 160 * MiB, A0_NVC = 169 * MiB, A0_NKS = 178 * MiB, A0_NKW = 186 * MiB, A0_NVST = 194 * MiB, A0_NVWT = 202 * MiB;
constexpr size_t A0_GLR = 210 * MiB, A0_NGATE = 211 * MiB;
constexpr size_t ACT_BYTES = 216 * MiB;
static_assert(A0_NVWT + 8 * MiB <= A0_GLR && A0_GLR + 1 * MiB <= A0_NGATE && A0_NGATE + 2 * MiB <= ACT_BYTES, "layer-0 act map");
constexpr size_t A1_HQ = 0, A1_HF = 32 * MiB, A1_HZ = 64 * MiB, A1_SZ = 96 * MiB, A1_BC = 128 * MiB, A1_HIT = 144 * MiB, A1_XST = 176 * MiB, A1_SDT = 208 * MiB, A1_BS = 209 * MiB, A1_DTV = 210 * MiB, A1_WJ = 211 * MiB;
static_assert(A1_WJ + 1 * MiB <= ACT_BYTES && A1_XST + 32 * MiB <= A1_SDT && WS_ACT + ACT_BYTES <= WS_CONCAT && WS_CONCAT + 64 * MiB <= WS_OW && WS_OW + 32 * MiB <= WS_U0 && WS_U0 + 16 * MiB <= WS_OC && WS_OC + 32 * MiB <= WS_END, "ws map");
constexpr int CW_BAR = 4096;

constexpr int RING_BYTES = 147456;
constexpr int LDSCTL_OFF = RING_BYTES, MISC_OFF = LDSCTL_OFF + 320;
constexpr int LDS_BYTES = RING_BYTES + 1024;
constexpr int NWAVES = 8, NTHR = 512;

struct Args { const float* in[27]; float* out; unsigned char* ws; int ph_lo, ph_hi; };
typedef const __attribute__((address_space(4))) Args CArgs;

#ifndef PROF_BID
#define PROF_BID -1
#endif
#ifndef PROF_SCALE
#define PROF_SCALE 1.0f
#endif
#if PROF_BID >= 0
DI void prof_lap(LAS unsigned char* lds, unsigned char* ws, int k) {
    if (blockIdx.x == PROF_BID && threadIdx.x == 0) {
        const unsigned long long now = __builtin_amdgcn_s_memrealtime();
        LAS unsigned long long* last = (LAS unsigned long long*)(lds + RING_BYTES + 64);
        unsigned long long* ts = (unsigned long long*)(ws + 32768);
        ts[k] += now - *last; *last = now;
    }
}
#ifdef PROF_SECTIONS
#define PROF(k) prof_lap(F.lds, a.ws, (k))
#else
#define PROF(k) do {} while (0)
#endif
#else
#define PROF(k) do {} while (0)
#endif
struct Frame {
    LAS unsigned char* lds;
    int tid, lane, wave, G, bid;
};
DI float wave_sum(float v) {
#pragma unroll
    for (int o = 1; o < 64; o <<= 1) v += __shfl_xor(v, o);
    return v;
}

DI int dperm(int p) { return (p >> 1) + 64 * (p & 1); }
DI int src_wn0(int n) {
    if (n < 1024) return n;
    if (n < 2048) return 2064 + (n - 1024);
    if (n < 3072) { const int r = n - 2048; return 3088 + (r & ~127) + dperm(r & 127); }
    if (n < 3328) { const int r = n - 3072; return 4112 + (r & ~127) + dperm(r & 127); }
    if (n < 3584) { const int r = n - 3328; return 4624 + (r & ~127) + dperm(r & 127); }
    if (n < 3840) { const int r = n - 3584; return 5136 + (r & ~127) + dperm(r & 127); }
    if (n < 4096) return 4368 + (n - 3840);
    if (n < 5120) return 5672 + (n - 4096);
    const int r = n - 5120; if (r < 16) return 2048 + r; if (r < 40) return 5648 + (r - 16); return -1;
}
DI int src_wt0(int n) { if (n < 1024) return 1024 + n; if (n < 1280) return 4880 + (n - 1024); return 5392 + (n - 1280); }
DI int src_wn1(int n) {
    if (n < 1024) return n;
    if (n < 2048) return n;
    if (n < 3072) return 3072 + (n - 2048);
    if (n < 4096) return 4096 + (n - 3072);
    if (n < 4608) return 6144 + (n - 4096);
    const int r = n - 4608; return r < 16 ? 6656 + r : -1;
}
DI int src_wt1(int n) { return n < 1024 ? 2048 + n : 5120 + (n - 1024); }
DI int inv_dperm(int d) { return d < 64 ? 2 * d : 2 * (d - 64) + 1; }
template <int MID> DI int tr_srccol(int n) {
    if constexpr (MID == 0) return src_wn0(n); else if constexpr (MID == 1) return src_wt0(n); else if constexpr (MID == 5) return src_wn1(n); else if constexpr (MID == 6) return src_wt1(n); else return n;
}
template <int MID> DI int tr_srcrow(int k) {
    if constexpr (MID == 3) return (k & ~127) + dperm(k & 127);
    else if constexpr (MID == 7) return k < 1024 ? 1024 + k : k - 1024;
    else return k;
}
template <int MID> DI void tr_item(const float* W, int ldw, bf16_t* WT, int Kd, int Nd, const float* kscale, LAS float* scr, int item, int lane) {
    const int nblk = Nd / 32, kb = item / nblk, nb = item % nblk, k0 = 64 * kb, n0 = 32 * nb;
    int c0 = tr_srccol<MID>(n0); const int c31 = tr_srccol<MID>(n0 + 31);
    bool perm = false; int db = 0, q0 = 0;
    if constexpr (MID == 0) { if (n0 >= 2048 && n0 < 3840) { perm = true; int sb;
            if (n0 < 3072) { db = 2048; sb = 3088; } else if (n0 < 3328) { db = 3072; sb = 4112; } else if (n0 < 3584) { db = 3328; sb = 4624; } else { db = 3584; sb = 5136; }
            q0 = n0 - db; c0 = sb + q0; } }
    if (perm || (c0 >= 0 && c31 - c0 == 31)) {
        const int kk0 = lane >> 3, g4 = (lane & 7) * 4;
        f32x4 v[8];
#pragma unroll
        for (int i = 0; i < 8; ++i) { const int kk = kk0 + 8 * i; v[i] = *(const f32x4*)(W + (size_t)tr_srcrow<MID>(k0 + kk) * ldw + c0 + g4); }
#pragma unroll
        for (int i = 0; i < 8; ++i) { const int kk = kk0 + 8 * i; f32x4 x = v[i];
            if constexpr (MID == 7) { if (k0 + kk < 1024) x = x * kscale[k0 + kk]; }
            scr[kk * 33 + g4] = x[0]; scr[kk * 33 + g4 + 1] = x[1]; scr[kk * 33 + g4 + 2] = x[2]; scr[kk * 33 + g4 + 3] = x[3]; }
    } else {
        const int sc = tr_srccol<MID>(n0 + (lane & 31));
#pragma unroll 8
        for (int i = 0; i < 32; ++i) { const int kk = 2 * i + (lane >> 5); const int sr = tr_srcrow<MID>(k0 + kk);
            float v = sc >= 0 ? W[(size_t)sr * ldw + sc] : 0.f;
            if constexpr (MID == 7) { if (k0 + kk < 1024) v *= kscale[k0 + kk]; }
            scr[kk * 33 + (lane & 31)] = v; }
    }
    asm volatile("s_waitcnt lgkmcnt(0)" ::: "memory");
    const int c = lane & 7;
#pragma unroll
    for (int j = 0; j < 4; ++j) { const int n = (lane >> 3) + 8 * j; const LAS float* s = scr + (8 * c) * 33 + n;
        u32x4 o; o.x = pk2(s[0 * 33], s[1 * 33]); o.y = pk2(s[2 * 33], s[3 * 33]); o.z = pk2(s[4 * 33], s[5 * 33]); o.w = pk2(s[6 * 33], s[7 * 33]);
        const int nrow = perm ? db + ((q0 + n) & ~127) + inv_dperm((q0 + n) & 127) : n0 + n;
        *(u32x4*)(WT + (size_t)nrow * Kd + k0 + 8 * c) = o; }
    asm volatile("s_waitcnt lgkmcnt(0)" ::: "memory");
}
DI void p0_weights(const Frame& F, CArgs& a, int part, int gw, int NGW) {
    unsigned char* ws = a.ws;
    LAS float* scr = (LAS float*)(F.lds + F.wave * 16384);
    constexpr int I0 = 32 * (NN0 / 32), I1 = 32 * (NT0 / 32), I2 = 32 * 64, I3 = 64 * 8, I4 = 64 * 8, I5 = 32 * (NN1 / 32), I6 = 32 * (NT1 / 32), I7 = 32 * 64;
    constexpr int NITEMS = I0 + I1 + I2 + I3 + I4 + I5 + I6 + I7;
    constexpr int NL0 = I0 + I1 + I2 + I3 + I4;
    const int it_lo = part == 0 ? 0 : part == 1 ? NL0 : NL0 + I5 + I6, it_hi = part == 0 ? NL0 : part == 1 ? NL0 + I5 + I6 : NITEMS;
    for (int it = it_lo + gw; it < it_hi; it += NGW) {
        int r = it;
        if (r < I0) { tr_item<0>(a.in[6], N_EVEN, (bf16_t*)(ws + WS_WN0), DM, NN0, nullptr, scr, r, F.lane); continue; } r -= I0;
        if (r < I1) { tr_item<1>(a.in[6], N_EVEN, (bf16_t*)(ws + WS_WT0), DM, NT0, nullptr, scr, r, F.lane); continue; } r -= I1;
        if (r < I2) { tr_item<2>(a.in[7], DM, (bf16_t*)(ws + WS_WO0), DM, DM, nullptr, scr, r, F.lane); continue; } r -= I2;
        if (r < I3) { tr_item<3>(a.in[12], 256, (bf16_t*)(ws + WS_W1K), 4096, 256, nullptr, scr, r, F.lane); continue; } r -= I3;
        if (r < I4) { tr_item<4>(a.in[15], 256, (bf16_t*)(ws + WS_W1V), 4096, 256, nullptr, scr, r, F.lane); continue; } r -= I4;
        if (r < I5) { tr_item<5>(a.in[17], N_ODD, (bf16_t*)(ws + WS_WN1), DM, NN1, nullptr, scr, r, F.lane); continue; } r -= I5;
        if (r < I6) { tr_item<6>(a.in[17], N_ODD, (bf16_t*)(ws + WS_WT1), DM, NT1, nullptr, scr, r, F.lane); continue; } r -= I6;
        tr_item<7>(a.in[18], DM, (bf16_t*)(ws + WS_WO1), DM, DM, a.in[26], scr, r, F.lane);
    }
}
DI void p0_prologue(const Frame& F, CArgs& a) {
    unsigned char* ws = a.ws;
    LAS float* scr = (LAS float*)(F.lds + F.wave * 16384);
    const int gw = F.bid * NWAVES + F.wave, NGW = F.G * NWAVES;
    PROF(80);
    __syncthreads();
    {
        LAS float* cact = (LAS float*)(F.lds);
        LAS float* red = (LAS float*)(F.lds + 16384);
        for (int e = F.tid; e < 2 * DM; e += NTHR) cact[e] = siluf_(a.in[1][e]);
        __syncthreads();
        for (int it = F.bid; it < 2 * 96; it += F.G) {
            const int l = it / 96, n0 = (it % 96) * 64, n = n0 + F.lane;
            const float* W = a.in[2] + (size_t)l * DM * 6144;
            float a0 = 0.f, a1 = 0.f;
            const int kb = F.wave * 256;
#pragma unroll 1
            for (int k = kb; k < kb + 256; k += 32) {
                float wv[32];
#pragma unroll
                for (int i = 0; i < 32; ++i) wv[i] = __builtin_nontemporal_load(W + (size_t)(k + i) * 6144 + n);
#pragma unroll
                for (int i = 0; i < 32; ++i) { a0 += cact[k + i] * wv[i]; a1 += cact[DM + k + i] * wv[i]; }
            }
            red[(F.wave * 2 + 0) * 64 + F.lane] = a0; red[(F.wave * 2 + 1) * 64 + F.lane] = a1;
            __syncthreads();
            if (F.tid < 128) { const int b = F.tid >> 6, ln = F.tid & 63; float s = 0.f;
#pragma unroll
                for (int w = 0; w < 8; ++w) s += red[(w * 2 + b) * 64 + ln];
                ((float*)(ws + WS_MOD))[(size_t)(l * 2 + b) * 6144 + n0 + ln] = s + a.in[3][l * 6144 + n0 + ln]; }
            __syncthreads();
        }
    }
    PROF(81);
    {
        const int gt = F.bid * NTHR + F.tid, NGT = F.G * NTHR;
        static_assert((256 * NTHR) % 64 == 0, "rope: a thread keeps its frequency index");
        double fr = 1.0; { const double r1 = 0.86596432336006535;
            const int i0 = gt & 63; for (int q = 0; q < i0; ++q) fr *= r1; }
        for (int e = gt; e < SEQ * 64; e += NGT) {
            const int pos = e >> 6;
            const float invf32 = (float)fr;
            const float angf = (float)pos * invf32;
            double x = (double)angf;
            const double TWO_PI = 6.283185307179586476925, INV_2PI = 0.15915494309189533577;
            double kq = __builtin_rint(x * INV_2PI); x -= kq * TWO_PI;
            const double HALF_PI = 1.5707963267948966192;
            double qd = __builtin_rint(x * 0.63661977236758134308); const double r = x - qd * HALF_PI; const int qi = ((int)qd) & 3;
            const double r2 = r * r;
            const double s = r * (1.0 + r2 * (-1.0 / 6 + r2 * (1.0 / 120 + r2 * (-1.0 / 5040 + r2 * (1.0 / 362880 + r2 * (-1.0 / 39916800 + r2 * (1.0 / 6227020800.0)))))));
            const double cc = 1.0 + r2 * (-0.5 + r2 * (1.0 / 24 + r2 * (-1.0 / 720 + r2 * (1.0 / 40320 + r2 * (-1.0 / 3628800 + r2 * (1.0 / 479001600.0 + r2 * (-1.0 / 87178291200.0)))))));
            double sn, cs;
            if (qi == 0) { sn = s; cs = cc; } else if (qi == 1) { sn = cc; cs = -s; } else if (qi == 2) { sn = -s; cs = -cc; } else { sn = -cc; cs = s; }
            ((f32x2*)(ws + WS_ROPE))[e] = (f32x2){(float)cs, (float)sn};
        }
    }
    PROF(82);
    if (F.bid == 0) { for (int d = F.tid; d < 1024; d += NTHR) { const float g0 = a.in[19][d], g1 = a.in[19][1024 + d]; ((float*)(ws + WS_LB))[d] = 1.f / (1.f + __expf(g0 - g1)); } }
    if (F.bid >= 1 && F.bid <= 128) {
        const int m = (F.bid - 1) >> 6, j = (F.bid - 1) & 63;
        const float* pe = a.in[m ? 14 : 11]; const float* w1 = a.in[m ? 15 : 12];
        LAS float* red = (LAS float*)(F.lds);
        const int cidx = F.tid & 255, kh = F.tid >> 8; float s0 = 0.f, s1 = 0.f;
        const int kb = 64 * j + 32 * kh;
#pragma unroll
        for (int k = 0; k < 32; k += 2) { s0 += pe[kb + k] * w1[(size_t)(kb + k) * 256 + cidx]; s1 += pe[kb + k + 1] * w1[(size_t)(kb + k + 1) * 256 + cidx]; }
        __syncthreads(); red[F.tid] = s0 + s1; __syncthreads();
        if (F.tid < 256) ((float*)(ws + WS_B1P))[(size_t)(m * 64 + j) * 256 + F.tid] = red[F.tid] + red[256 + F.tid];
        __syncthreads();
    }
}

DI void load_row_f32(const float* row, int lane, f32x4 (&v)[8]) {
#pragma unroll
    for (int j = 0; j < 8; ++j) v[j] = *(const f32x4*)(row + 4 * lane + 256 * j);
}
DI float sumsq8(const f32x4 (&v)[8]) { float s = 0.f;
#pragma unroll
    for (int j = 0; j < 8; ++j) s += (v[j].x * v[j].x + v[j].y * v[j].y) + (v[j].z * v[j].z + v[j].w * v[j].w);
    return wave_sum(s); }
DI void modulate_store(const f32x4 (&v)[8], float rs, const float* w, const float* mod  , bf16_t* hrow, int lane) {
#pragma unroll
    for (int j = 0; j < 8; ++j) { const int c = 4 * lane + 256 * j;
        const f32x4 ww = *(const f32x4*)(w + c), sh = *(const f32x4*)(mod + c), sc = *(const f32x4*)(mod + 2048 + c);
        const f32x4 o = v[j] * rs * ww * (sc + 1.0f) + sh;
        u32x2 p; p.x = pk2(o.x, o.y); p.y = pk2(o.z, o.w); *(u32x2*)(hrow + c) = p; }
}
DI void stage_table(LAS float* dst, const float* src, int tid) {
    for (int e = tid; e < 512; e += NTHR) *(LAS f32x4*)(dst + 4 * e) = *(const f32x4*)(src + 4 * e);
}
DI void modulate_store_lds(const f32x4 (&v)[8], float rs, const LAS float* w, const LAS float* sh, const LAS float* sc, bf16_t* hrow, int lane) {
#pragma unroll
    for (int j = 0; j < 8; ++j) { const int c = 4 * lane + 256 * j;
        const f32x4 ww = *(const LAS f32x4*)(w + c), s0 = *(const LAS f32x4*)(sh + c), s1 = *(const LAS f32x4*)(sc + c);
        const f32x4 o = v[j] * rs * ww * (s1 + 1.0f) + s0;
        u32x2 p; p.x = pk2(o.x, o.y); p.y = pk2(o.z, o.w); *(u32x2*)(hrow + c) = p; }
}
DI void p1_prenorm0(const Frame& F, CArgs& a) {
    const int gw = F.bid * NWAVES + F.wave, NGW = F.G * NWAVES;
    bf16_t* H = (bf16_t*)(a.ws + WS_HY);
    LAS float* TB = (LAS float*)F.lds;
    const float* MOD = (const float*)(a.ws + WS_MOD);
    __syncthreads();
    stage_table(TB, a.in[4], F.tid);
    stage_table(TB + 2048, MOD, F.tid); stage_table(TB + 4096, MOD + 6144, F.tid);
    stage_table(TB + 6144, MOD + 2048, F.tid); stage_table(TB + 8192, MOD + 6144 + 2048, F.tid);
    __syncthreads();
    f32x4 xn[8]; int m = gw;
    if (m < MTOK) load_row_f32(a.in[0] + (size_t)m * DM, F.lane, xn);
    for (; m < MTOK; m += NGW) {
        f32x4 v[8];
#pragma unroll
        for (int j = 0; j < 8; ++j) v[j] = xn[j];
        if (m + NGW < MTOK) load_row_f32(a.in[0] + (size_t)(m + NGW) * DM, F.lane, xn);
        const float rs = 1.0f / sqrtf(sumsq8(v) * (1.0f / DM) + EPS);
        const int bsel = m >> 13;
        modulate_store_lds(v, rs, TB, TB + 2048 + bsel * 2048, TB + 6144 + bsel * 2048, H + (size_t)m * DM, F.lane);
    }
    __syncthreads();
}
template <int LAYER> DI void p_residual(const Frame& F, CArgs& a) {
    const int gw = F.bid * NWAVES + F.wave, NGW = F.G * NWAVES;
    bf16_t* HY = (bf16_t*)(a.ws + WS_HY);
    const float* xin = LAYER == 0 ? a.in[0] : a.out;
    LAS float* TB = (LAS float*)F.lds;
    const float* MOD = (const float*)(a.ws + WS_MOD);
    __syncthreads();
    stage_table(TB, a.in[5] + LAYER * DM, F.tid);
    stage_table(TB + 2048, MOD + (size_t)(LAYER * 2 + 0) * 6144 + 4096, F.tid); stage_table(TB + 4096, MOD + (size_t)(LAYER * 2 + 1) * 6144 + 4096, F.tid);
    if constexpr (LAYER == 0) {
        stage_table(TB + 6144, a.in[4] + DM, F.tid);
        stage_table(TB + 8192, MOD + (size_t)2 * 6144, F.tid); stage_table(TB + 10240, MOD + (size_t)3 * 6144, F.tid);
        stage_table(TB + 12288, MOD + (size_t)2 * 6144 + 2048, F.tid); stage_table(TB + 14336, MOD + (size_t)3 * 6144 + 2048, F.tid);
    }
    __syncthreads();
    u32x2 yn[8]; f32x4 xn[8]; int m = gw;
    if (m < MTOK) {
#pragma unroll
        for (int j = 0; j < 8; ++j) yn[j] = *(const u32x2*)(HY + (size_t)m * DM + 4 * F.lane + 256 * j);
        load_row_f32(xin + (size_t)m * DM, F.lane, xn);
    }
    for (; m < MTOK; m += NGW) {
        f32x4 y[8], x[8];
#pragma unroll
        for (int j = 0; j < 8; ++j) { const u32x2 p = yn[j]; y[j] = (f32x4){bflo(p.x), bfhi(p.x), bflo(p.y), bfhi(p.y)}; x[j] = xn[j]; }
        if (m + NGW < MTOK) {
#pragma unroll
            for (int j = 0; j < 8; ++j) yn[j] = *(const u32x2*)(HY + (size_t)(m + NGW) * DM + 4 * F.lane + 256 * j);
            load_row_f32(xin + (size_t)(m + NGW) * DM, F.lane, xn);
        }
        const float rsy = 1.0f / sqrtf(sumsq8(y) * (1.0f / DM) + EPS);
        const int bsel = m >> 13;
#pragma unroll
        for (int j = 0; j < 8; ++j) { const int c = 4 * F.lane + 256 * j;
            const f32x4 pw = *(const LAS f32x4*)(TB + c), gt = *(const LAS f32x4*)(TB + 2048 + bsel * 2048 + c);
            x[j] = x[j] + gt * (y[j] * rsy * pw);
            *(f32x4*)(a.out + (size_t)m * DM + c) = x[j]; }
        if constexpr (LAYER == 0) {
            const float rs = 1.0f / sqrtf(sumsq8(x) * (1.0f / DM) + EPS);
            modulate_store_lds(x, rs, TB + 6144, TB + 8192 + bsel * 2048, TB + 12288 + bsel * 2048, HY + (size_t)m * DM, F.lane);
        }
    }
    __syncthreads();
}
constexpr float QSCALE_GLA = 0.08838834764831845f;
constexpr float QSCALE_NSA = 0.12751743082459868f;
template <int LAYER> struct EpiProj {
    static constexpr bool PERM = true;
    unsigned char* ws;
    DI bool operator()(f32x4 (&acc)[2][2][4][2], const pg8::Unit& u, int wr, int wc, int fr, int fq) const {
        unsigned char* act = ws + WS_ACT;
        int mode = 0, ldc = 1024, coff = 0; size_t boff = 0; float sc = 1.f;
        const int pn = u.pn, pm = u.pm;
        if constexpr (LAYER == 0) {
            if (u.job == 0) {
                if (pn < 2)       { boff = A0_GQ; ldc = 512; coff = pn * 256; sc = QSCALE_GLA; }
                else if (pn < 4)  { boff = A0_GK; ldc = 512; coff = (pn - 2) * 256; }
                else if (pn < 8)  { boff = A0_GZ; coff = (pn - 4) * 256; }
                else if (pn < 12) { boff = A0_NQ; coff = (pn - 8) * 256; mode = 1; sc = QSCALE_NSA; }
                else if (pn == 12) { boff = A0_NKC; mode = 2; }
                else if (pn == 13) { boff = A0_NKS; mode = 2; }
                else if (pn == 14) { boff = A0_NKW; mode = 2; }
                else if (pn == 15) { boff = A0_NVC; mode = 3; }
                else if (pn < 20) { boff = A0_NZ; coff = (pn - 16) * 256; }
                else mode = 4;
            } else {
                if (pm < 4) { boff = A0_GVT; ldc = MTOK; coff = pn * 256; }
                else { boff = pm == 4 ? A0_NVST : A0_NVWT; mode = 6; }
            }
        } else {
            if (u.job == 0) {
                if (pn < 4)       { boff = A1_HQ; coff = pn * 256; }
                else if (pn < 8)  { boff = A1_HF; coff = (pn - 4) * 256; }
                else if (pn < 12) { boff = A1_HZ; coff = (pn - 8) * 256; }
                else if (pn < 16) { boff = A1_SZ; coff = (pn - 12) * 256; }
                else if (pn < 18) { boff = A1_BC; ldc = 512; coff = (pn - 16) * 256; }
                else mode = 4;
            } else {
                if (pm < 4) { boff = A1_HIT; ldc = MTOK; coff = pn * 256; }
                else { boff = A1_XST - (size_t)1024 * MTOK * 2; ldc = MTOK; coff = pn * 256; }
            }
        }
        bf16_t* base = (bf16_t*)(act + boff);
        const f32x2* rope = (const f32x2*)(ws + WS_ROPE);
#pragma unroll
        for (int ai = 0; ai < 2; ++ai)
#pragma unroll
            for (int m = 0; m < 4; ++m) {
                const int row = pm * 256 + ai * 128 + wr * 64 + m * 16 + fr;
#pragma unroll
                for (int bj = 0; bj < 2; ++bj) {
                    const int c8 = bj * 128 + wc * 32 + 8 * fq;
                    f32x4 v0 = acc[ai][bj][m][0], v1 = acc[ai][bj][m][1];
                    if (mode == 4) {
                        if constexpr (LAYER == 0) {
                            if (c8 < 16) { float* d = (float*)(act + A0_GLR) + (size_t)row * 16 + c8; *(f32x4*)d = v0; *(f32x4*)(d + 4) = v1; }
                            else if (c8 < 40) { float* d = (float*)(act + A0_NGATE) + (size_t)row * 24 + (c8 - 16);
                                f32x4 g0, g1;
#pragma unroll
                                for (int e = 0; e < 4; ++e) { g0[e] = sigmoidf_(v0[e]); g1[e] = sigmoidf_(v1[e]); }
                                *(f32x4*)d = g0; *(f32x4*)(d + 4) = g1; }
                        } else {
                            if (c8 < 16) { float* d = (float*)(act + A1_SDT) + (size_t)row * 16 + c8; *(f32x4*)d = v0; *(f32x4*)(d + 4) = v1; }
                        }
                        continue;
                    }
                    if (mode == 1 || mode == 2) {
                        const int i0 = (c8 & 127) >> 1;
                        const f32x4* cs = (const f32x4*)(rope + (size_t)(row & (SEQ - 1)) * 64 + i0);
                        const f32x4 c01 = cs[0], c23 = cs[1];
                        f32x4 r0, r1;
                        r0[0] = v0[0] * c01[0] - v0[1] * c01[1]; r0[1] = v0[0] * c01[1] + v0[1] * c01[0];
                        r0[2] = v0[2] * c01[2] - v0[3] * c01[3]; r0[3] = v0[2] * c01[3] + v0[3] * c01[2];
                        r1[0] = v1[0] * c23[0] - v1[1] * c23[1]; r1[1] = v1[0] * c23[1] + v1[1] * c23[0];
                        r1[2] = v1[2] * c23[2] - v1[3] * c23[3]; r1[3] = v1[2] * c23[3] + v1[3] * c23[2];
                        v0 = r0; v1 = r1;
                    }
                    v0 = v0 * sc; v1 = v1 * sc;
                    u32x4 w; w.x = pk2(v0[0], v0[1]); w.y = pk2(v0[2], v0[3]); w.z = pk2(v1[0], v1[1]); w.w = pk2(v1[2], v1[3]);
                    bf16_t* dst;
                    if (mode == 2 || mode == 3) dst = base + ((size_t)(((row >> 13) * 2 + (c8 >> 7)) * SEQ + (row & (SEQ - 1)))) * 128 + (c8 & 127);
                    else if (mode == 6) { const int fl = row & 255, tok = pn * 256 + c8; dst = base + ((size_t)(((tok >> 13) * 2 + (fl >> 7)) * 128 + (fl & 127))) * SEQ + (tok & (SEQ - 1)); }
                    else dst = base + (size_t)row * ldc + coff + c8;
                    *(u32x4*)dst = w;
                }
            }
        return false;
    }
};
struct EpiBf16 {
    static constexpr bool PERM = true;
    bf16_t* O; int ldc;
    DI bool operator()(f32x4 (&acc)[2][2][4][2], const pg8::Unit& u, int wr, int wc, int fr, int fq) const {
#pragma unroll
        for (int ai = 0; ai < 2; ++ai)
#pragma unroll
            for (int m = 0; m < 4; ++m) { bf16_t* rowp = O + (size_t)(u.pm * 256 + ai * 128 + wr * 64 + m * 16 + fr) * ldc + u.pn * 256 + wc * 32 + 8 * fq;
#pragma unroll
                for (int bj = 0; bj < 2; ++bj) { const f32x4 v0 = acc[ai][bj][m][0], v1 = acc[ai][bj][m][1];
                    u32x4 w; w.x = pk2(v0[0], v0[1]); w.y = pk2(v0[2], v0[3]); w.z = pk2(v1[0], v1[1]); w.w = pk2(v1[2], v1[3]);
                    *(u32x4*)(rowp + bj * 128) = w; } }
        return false;
    }
};
struct EpiBf16Mid {
    static constexpr bool PERM = true;
    bf16_t* O; int ldc; const float* rtab;
    DI bool operator()(f32x4 (&acc)[2][2][4][2], const pg8::Unit& u, int wr, int wc, int fr, int fq) const {
        if (u.ks == 0) {
#pragma unroll
            for (int ai = 0; ai < 2; ++ai)
#pragma unroll
                for (int m = 0; m < 4; ++m) { const float r = rtab[u.pm * 256 + ai * 128 + wr * 64 + m * 16 + fr];
#pragma unroll
                    for (int bj = 0; bj < 2; ++bj) { acc[ai][bj][m][0] = acc[ai][bj][m][0] * r; acc[ai][bj][m][1] = acc[ai][bj][m][1] * r; } }
            return true;
        }
        EpiBf16 e{O, ldc}; return e(acc, u, wr, wc, fr, fq);
    }
};
struct EpiF32Part {
    static constexpr bool PERM = true;
    float* P;
    DI bool operator()(f32x4 (&acc)[2][2][4][2], const pg8::Unit& u, int wr, int wc, int fr, int fq) const {
        float* base = P + (size_t)(u.job * 8 + u.ks) * 2048 * 256;
#pragma unroll
        for (int ai = 0; ai < 2; ++ai)
#pragma unroll
            for (int m = 0; m < 4; ++m) { float* rowp = base + (size_t)(u.pm * 256 + ai * 128 + wr * 64 + m * 16 + fr) * 256 + wc * 32 + 8 * fq;
#pragma unroll
                for (int bj = 0; bj < 2; ++bj) { *(f32x4*)(rowp + bj * 128) = acc[ai][bj][m][0]; *(f32x4*)(rowp + bj * 128 + 4) = acc[ai][bj][m][1]; } }
        return false;
    }
};
template <int MODE> struct LACfg;
template <> struct LACfg<0> { static constexpr int CL = 64, NH = 1, HA = 1, NCH = 8; };
template <> struct LACfg<1> { static constexpr int CL = 32, NH = 2, HA = 2, NCH = 16; };
template <> struct LACfg<2> { static constexpr int CL = 64, NH = 1, HA = 4, NCH = 8; };
constexpr int LA_NSC = 16, LA_ITEMS = 128;
DI float log_sigmoid_(float x) { return fminf(x, 0.f) - __logf(1.0f + __expf(-fabsf(x))); }
DI float softplus_(float x) { return fmaxf(x, 0.f) + __logf(1.0f + __expf(-fabsf(x))); }

template <int MODE> DI void la_prep(const Frame& F, CArgs& a, int item) {
    typedef LACfg<MODE> C;
    constexpr int CL = C::CL, NH = C::NH, PQ = 272;
    constexpr int O_Q = 0, O_K = O_Q + NH * CL * PQ, O_RAW = O_K + NH * CL * PQ, O_GS = O_RAW + 4096;
    LAS unsigned char* L = F.lds; unsigned char* ws = a.ws; unsigned char* act = ws + WS_ACT;
    const int tid = F.tid;
    const int c = item % (SEQ / CL), bh = item / (SEQ / CL), b = bh >> 2, hx = bh & 3;
    const size_t tok0 = (size_t)b * SEQ + (size_t)c * CL;
    bf16_t* kg; bf16_t* qg; int ldk;
    if constexpr (MODE == 0) { kg = (bf16_t*)(act + A0_GK) + tok0 * 512 + hx * 128; qg = (bf16_t*)(act + A0_GQ) + tok0 * 512 + hx * 128; ldk = 512; }
    else { kg = (bf16_t*)(act + A1_HF) + tok0 * 1024 + hx * 256; qg = (bf16_t*)(act + A1_HQ) + tok0 * 1024 + hx * 256; ldk = 1024; }
    __syncthreads();
    { u32x4 kq[4];
#pragma unroll
        for (int i = 0; i < 2; ++i) { const int ci = tid + 512 * i, hh2 = (NH == 2) ? (ci >> 9) : 0, j = (ci >> 4) & (CL - 1), cc = ci & 15;
            kq[i] = *(const u32x4*)(kg + (size_t)j * ldk + hh2 * 128 + cc * 8); kq[2 + i] = *(const u32x4*)(qg + (size_t)j * ldk + hh2 * 128 + cc * 8); }
        f32x4 gr = {0.f, 0.f, 0.f, 0.f};
        if constexpr (MODE == 0) { if (tid < 256) gr = *(const f32x4*)((const float*)(act + A0_GLR) + tok0 * 16 + tid * 4); }
#pragma unroll
        for (int i = 0; i < 2; ++i) { const int ci = tid + 512 * i, hh2 = (NH == 2) ? (ci >> 9) : 0, j = (ci >> 4) & (CL - 1), cc = ci & 15;
            *(LAS u32x4*)(L + O_K + (hh2 * CL + j) * PQ + cc * 16) = kq[i]; *(LAS u32x4*)(L + O_Q + (hh2 * CL + j) * PQ + cc * 16) = kq[2 + i]; }
        if constexpr (MODE == 0) { if (tid < 256) *(LAS f32x4*)(L + O_RAW + tid * 16) = gr; } }
    if constexpr (MODE == 0) {
        const int d = tid & 127, jg = tid >> 7;
        float wu[16];
#pragma unroll
        for (int r = 0; r < 16; ++r) wu[r] = a.in[8][r * 512 + hx * 128 + d];
        const float bu = a.in[9][hx * 128 + d];
        __syncthreads();
        float lg[16]; float run = 0.f;
#pragma unroll
        for (int jj = 0; jj < 16; ++jj) { const LAS f32x4* gl = (const LAS f32x4*)(L + O_RAW + (jg * 16 + jj) * 64);
            const f32x4 g0 = gl[0], g1 = gl[1], g2 = gl[2], g3 = gl[3];
            float x = bu;
#pragma unroll
            for (int e = 0; e < 4; ++e) { x += g0[e] * wu[e]; x += g1[e] * wu[4 + e]; x += g2[e] * wu[8 + e]; x += g3[e] * wu[12 + e]; }
            run += log_sigmoid_(x) * (1.0f / 16.0f); lg[jj] = run; }
        ((LAS float*)(L + O_GS))[jg * 128 + d] = run;
        __syncthreads();
        float pre = 0.f, tot = 0.f;
#pragma unroll
        for (int g = 0; g < 4; ++g) { const float v = ((LAS float*)(L + O_GS))[g * 128 + d]; if (g < jg) pre += v; tot += v; }
        if (jg == 0) ((float*)(ws + WS_BL))[(size_t)item * 128 + d] = tot;
#pragma unroll
        for (int jj = 0; jj < 16; ++jj) { const int j = jg * 16 + jj; const float bb = pre + lg[jj];
            LAS unsigned short* kp = (LAS unsigned short*)(L + O_K + j * PQ + d * 2); LAS unsigned short* qp = (LAS unsigned short*)(L + O_Q + j * PQ + d * 2);
            const unsigned pk = pk2(bf2f(*kp) * __expf(-bb), bf2f(*qp) * __expf(bb)); *kp = (unsigned short)(pk & 0xffffu); *qp = (unsigned short)(pk >> 16); }
    } else {
        const int d = tid & 127, hh = (tid >> 7) & 1, jg = tid >> 8;
        const float lbv = ((const float*)(ws + WS_LB))[(2 * hx + hh) * 128 + d];
        __syncthreads();
        float lg[16], kk[16]; float run = 0.f;
#pragma unroll
        for (int jj = 0; jj < 16; ++jj) { const float z = bf2f(*(const LAS unsigned short*)(L + O_K + (hh * CL + jg * 16 + jj) * PQ + d * 2));
            const float sg = __builtin_amdgcn_rcpf(1.0f + __expf(-z));
            run += __logf(lbv + (1.f - lbv) * sg); lg[jj] = run; kk[jj] = (1.f - lbv) * (1.f - sg); }
        ((LAS float*)(L + O_GS))[jg * 256 + hh * 128 + d] = run;
        __syncthreads();
        const float g0 = ((LAS float*)(L + O_GS))[hh * 128 + d], g1 = ((LAS float*)(L + O_GS))[256 + hh * 128 + d];
        if (jg == 0) ((float*)(ws + WS_BL))[(size_t)item * 256 + hh * 128 + d] = g0 + g1;
        const float pre = jg ? g0 : 0.f;
#pragma unroll
        for (int jj = 0; jj < 16; ++jj) { const int j = jg * 16 + jj; const float bb = pre + lg[jj];
            LAS unsigned short* kp = (LAS unsigned short*)(L + O_K + (hh * CL + j) * PQ + d * 2); LAS unsigned short* qp = (LAS unsigned short*)(L + O_Q + (hh * CL + j) * PQ + d * 2);
            const unsigned pk = pk2(kk[jj] * __expf(-bb), bf2f(*qp) * __expf(bb)); *kp = (unsigned short)(pk & 0xffffu); *qp = (unsigned short)(pk >> 16); }
    }
    __syncthreads();
    {
        bf16_t* ktg = (bf16_t*)(ws + WS_HY) + (size_t)item * (NH * 128 * CL);
        constexpr int TPR = CL / 8;
#pragma unroll
        for (int i = 0; i < NH * 128 * TPR / NTHR; ++i) { const int pi = tid + NTHR * i, row = pi / TPR, pc = pi % TPR, hh2 = row >> 7, d = row & 127;
            unsigned wv[4];
#pragma unroll
            for (int e = 0; e < 4; ++e) { const unsigned lo = *(const LAS unsigned short*)(L + O_K + (hh2 * CL + pc * 8 + 2 * e) * PQ + d * 2), hi = *(const LAS unsigned short*)(L + O_K + (hh2 * CL + pc * 8 + 2 * e + 1) * PQ + d * 2); wv[e] = lo | (hi << 16); }
            *(u32x4*)(ktg + (size_t)row * CL + pc * 8) = (u32x4){wv[0], wv[1], wv[2], wv[3]}; } }
#pragma unroll
    for (int i = 0; i < 2; ++i) { const int ci = tid + 512 * i, hh2 = (NH == 2) ? (ci >> 9) : 0, j = (ci >> 4) & (CL - 1), cc = ci & 15;
        *(u32x4*)(kg + (size_t)j * ldk + hh2 * 128 + cc * 8) = *(const LAS u32x4*)(L + O_K + (hh2 * CL + j) * PQ + cc * 16);
        *(u32x4*)(qg + (size_t)j * ldk + hh2 * 128 + cc * 8) = *(const LAS u32x4*)(L + O_Q + (hh2 * CL + j) * PQ + cc * 16); }
}
DI float silu_fast(float x) { return x * __builtin_amdgcn_rcpf(1.0f + __expf(-x)); }
DI void ssd_prep(const Frame& F, CArgs& a) {
    unsigned char* ws = a.ws; unsigned char* act = ws + WS_ACT;
    const int gt = F.bid * NTHR + F.tid, NGT = F.G * NTHR;
    for (int it = gt; it < 1024 * 512; it += NGT) { const int ch = it >> 9, run = it & 511; const size_t t0 = (size_t)run * 32;
        const bf16_t* rp = (const bf16_t*)(act + A1_XST) + (size_t)ch * MTOK + t0; bf16_t* op = (bf16_t*)(ws + WS_OC) + (size_t)ch * MTOK + t0;
        const float w0 = a.in[21][ch], w1 = a.in[21][1536 + ch], w2 = a.in[21][2 * 1536 + ch], w3 = a.in[21][3 * 1536 + ch], cb = a.in[22][ch];
        u32x4 p[4];
#pragma unroll
        for (int q = 0; q < 4; ++q) p[q] = *(const u32x4*)(rp + 8 * q);
        float x0 = 0.f, x1 = 0.f, x2 = 0.f;
        if ((t0 & (SEQ - 1)) != 0) { const u32x2 h2 = *(const u32x2*)(rp - 4); x0 = bfhi(h2.x); x1 = bflo(h2.y); x2 = bfhi(h2.y); }
#pragma unroll
        for (int q = 0; q < 4; ++q) { unsigned o[4];
#pragma unroll
            for (int e = 0; e < 4; ++e) { const float xa = bflo(p[q][e]), xb = bfhi(p[q][e]);
                const float ya = silu_fast(cb + w0 * x0 + w1 * x1 + w2 * x2 + w3 * xa), yb = silu_fast(cb + w0 * x1 + w1 * x2 + w2 * xa + w3 * xb);
                x0 = x2; x1 = xa; x2 = xb; o[e] = pk2(ya, yb); }
            *(u32x4*)(op + 8 * q) = (u32x4){o[0], o[1], o[2], o[3]}; } }
    for (int it = gt; it < 2048 * 64; it += NGT) { const int run = it >> 6, cg = it & 63; const size_t t0 = (size_t)run * 8;
        const bf16_t* rp = (const bf16_t*)(act + A1_BC) + t0 * 512 + cg * 8; bf16_t* op = (bf16_t*)(ws + WS_U0) + t0 * 512 + cg * 8;
        const int ch = 1024 + cg * 8;
        u32x4 r[11];
        const int tpos = (int)(t0 & (SEQ - 1));
#pragma unroll
        for (int k = 0; k < 11; ++k) { r[k] = (u32x4){0u, 0u, 0u, 0u}; if (tpos + k - 3 >= 0) r[k] = *(const u32x4*)(rp + (long)(k - 3) * 512); }
        f32x4 wa[4], wb[4]; const f32x4 ba = *(const f32x4*)(a.in[22] + ch), bb = *(const f32x4*)(a.in[22] + ch + 4);
#pragma unroll
        for (int k = 0; k < 4; ++k) { wa[k] = *(const f32x4*)(a.in[21] + k * 1536 + ch); wb[k] = *(const f32x4*)(a.in[21] + k * 1536 + ch + 4); }
        float yt[8][8];
#pragma unroll
        for (int t = 0; t < 8; ++t) { float y[8];
#pragma unroll
            for (int e = 0; e < 4; ++e) { float s0 = ba[e], s1 = bb[e];
#pragma unroll
                for (int k = 0; k < 4; ++k) { const u32x4 x = r[t + k]; const float xa = (e & 1) ? bfhi(x[e >> 1]) : bflo(x[e >> 1]); const float xb = (e & 1) ? bfhi(x[2 + (e >> 1)]) : bflo(x[2 + (e >> 1)]);
                    s0 += wa[k][e] * xa; s1 += wb[k][e] * xb; }
                y[e] = silu_fast(s0); y[4 + e] = silu_fast(s1); }
            *(u32x4*)(op + (size_t)t * 512) = (u32x4){pk2(y[0], y[1]), pk2(y[2], y[3]), pk2(y[4], y[5]), pk2(y[6], y[7])};
#pragma unroll
            for (int e = 0; e < 8; ++e) yt[e][t] = y[e]; }
        if (cg < 32) {
            const int g = cg >> 4, n0 = (cg & 15) * 8; const size_t ck = t0 >> 6; const int j0 = (int)(t0 & 63);
            bf16_t* bt = (bf16_t*)(ws + WS_HY + 32 * MiB) + ((ck * 2 + g) * 128 + n0) * 64 + j0;
#pragma unroll
            for (int e = 0; e < 8; ++e) *(u32x4*)(bt + e * 64) = (u32x4){pk2(yt[e][0], yt[e][1]), pk2(yt[e][2], yt[e][3]), pk2(yt[e][4], yt[e][5]), pk2(yt[e][6], yt[e][7])}; } }
    { const int gw = F.bid * NWAVES + F.wave, NGW = F.G * NWAVES, j = F.lane;
        for (int it = gw; it < 256 * 16; it += NGW) { const int head = it & 15, ck = it >> 4; const size_t gi = ((size_t)ck * 64 + j) * 16 + head;
            const float dtv = softplus_(((const float*)(act + A1_SDT))[gi] + a.in[23][head]);
            float bs = dtv * (-__expf(a.in[24][head]));
#pragma unroll
            for (int o = 1; o < 64; o <<= 1) { const float t = __shfl_up(bs, o); if (j >= o) bs += t; }
            const float bl = __shfl(bs, 63);
            ((float*)(act + A1_BS))[gi] = bs; ((float*)(act + A1_DTV))[gi] = dtv; ((float*)(act + A1_WJ))[gi] = __expf(bl - bs) * dtv; } }
}

DI void hgrn_prep_cols(const Frame& F, CArgs& a) {
    unsigned char* ws = a.ws; unsigned char* act = ws + WS_ACT;
    const int gt = F.bid * NTHR + F.tid, NGT = F.G * NTHR;
    constexpr int NIT = 2 * 8 * 256 * 64;
    auto addr = [&](int u, bf16_t*& zp, bf16_t*& qp) { const int idx = gt + (u >> 1) * NGT, hf = u & 1;
        const int d = (idx & 63) * 2, c = (idx >> 6) & 255, bhd = idx >> 14, head = bhd & 7, b = bhd >> 3;
        const size_t tok0 = (size_t)b * SEQ + (size_t)c * 32 + 16 * hf;
        zp = (bf16_t*)(act + A1_HF) + tok0 * 1024 + head * 128 + d; qp = (bf16_t*)(act + A1_HQ) + tok0 * 1024 + head * 128 + d; };
    const int nstep = 2 * ((NIT - gt + NGT - 1) / NGT);
    unsigned zn[16], qn[16];
    if (nstep > 0) { bf16_t* zp; bf16_t* qp; addr(0, zp, qp);
#pragma unroll
        for (int j = 0; j < 16; ++j) { zn[j] = *(const unsigned*)(zp + (size_t)j * 1024); qn[j] = *(const unsigned*)(qp + (size_t)j * 1024); } }
    float p0 = 1.f, p1 = 1.f;
#pragma unroll 1
    for (int u = 0; u < nstep; ++u) {
        const int idx = gt + (u >> 1) * NGT, hf = u & 1;
        const int d = (idx & 63) * 2, c = (idx >> 6) & 255, bhd = idx >> 14, head = bhd & 7, b = bhd >> 3;
        bf16_t* zp; bf16_t* qp; addr(u, zp, qp);
        unsigned zr[16], qr[16];
#pragma unroll
        for (int j = 0; j < 16; ++j) { zr[j] = zn[j]; qr[j] = qn[j]; }
        if (u + 1 < nstep) { bf16_t* zp2; bf16_t* qp2; addr(u + 1, zp2, qp2);
#pragma unroll
            for (int j = 0; j < 16; ++j) { zn[j] = *(const unsigned*)(zp2 + (size_t)j * 1024); qn[j] = *(const unsigned*)(qp2 + (size_t)j * 1024); } }
        const f32x2 lbv = *(const f32x2*)((const float*)(ws + WS_LB) + head * 128 + d);
        if (hf == 0) { p0 = 1.f; p1 = 1.f; }
        unsigned kt0[8], kt1[8];
#pragma unroll
        for (int j = 0; j < 16; ++j) {
            const float e0 = __expf(-bflo(zr[j])), e1 = __expf(-bfhi(zr[j]));
            const float sg0 = __builtin_amdgcn_rcpf(1.0f + e0), sg1 = __builtin_amdgcn_rcpf(1.0f + e1);
            p0 *= lbv.x + (1.f - lbv.x) * sg0; p1 *= lbv.y + (1.f - lbv.y) * sg1;
            const unsigned kk = pk2((1.f - lbv.x) * (1.f - sg0) * __builtin_amdgcn_rcpf(p0), (1.f - lbv.y) * (1.f - sg1) * __builtin_amdgcn_rcpf(p1));
            const unsigned qq = pk2(bflo(qr[j]) * p0, bfhi(qr[j]) * p1);
            *(unsigned*)(zp + (size_t)j * 1024) = kk; *(unsigned*)(qp + (size_t)j * 1024) = qq;
            if (j & 1) { kt0[j >> 1] |= (kk & 0xffffu) << 16; kt1[j >> 1] |= kk & 0xffff0000u; } else { kt0[j >> 1] = kk & 0xffffu; kt1[j >> 1] = kk >> 16; } }
        const int citem = (b * 4 + (head >> 1)) * 256 + c;
        bf16_t* ktg = (bf16_t*)(ws + WS_HY) + (size_t)citem * (2 * 128 * 32) + (size_t)((head & 1) * 128 + d) * 32;
#pragma unroll
        for (int q = 0; q < 2; ++q) { *(u32x4*)(ktg + 16 * hf + 8 * q) = (u32x4){kt0[4 * q], kt0[4 * q + 1], kt0[4 * q + 2], kt0[4 * q + 3]};
            *(u32x4*)(ktg + 32 + 16 * hf + 8 * q) = (u32x4){kt1[4 * q], kt1[4 * q + 1], kt1[4 * q + 2], kt1[4 * q + 3]}; }
        if (hf == 1) *(f32x2*)((float*)(ws + WS_BL) + (size_t)citem * 256 + (head & 1) * 128 + d) = (f32x2){__logf(p0), __logf(p1)};
    }
}
template <int MODE, int PHASE, bool SCANNED = false> DI void la_phase(const Frame& F, CArgs& a, int item_first, int item_stride) {
    typedef LACfg<MODE> C;
    constexpr int CL = C::CL, NH = C::NH, HA = C::HA, NI = CL / 32, PQ = 272  , PJ = (CL + 8) * 2  ;
    constexpr int O_QH = 0, O_KH = O_QH + NH * CL * PQ, O_KT = O_KH + NH * CL * PQ, O_VT = O_KT + NH * 128 * PJ, O_ATT = O_VT + 256 * PJ, O_DEC = O_ATT + HA * CL * PJ,
                  O_GS = O_DEC + 1024, O_RED = O_GS + 4096, O_BS = O_RED + 2048, O_DT = O_BS + 1024, O_WJ = O_DT + 1024, O_LS = O_WJ + 1024, O_ENDL = O_LS + 1024;
    static_assert(O_ENDL <= RING_BYTES, "LA LDS");
    LAS unsigned char* L = F.lds;
    unsigned char* ws = a.ws; unsigned char* act = ws + WS_ACT;
    const int tid0 = F.tid, w = F.wave;
#define LAUNDER() int tid = tid0; asm volatile("" : "+v"(tid)); const int lane = tid & 63, r32 = lane & 31, h = lane >> 5; (void)lane; (void)r32; (void)h
    float* Ubase = (float*)(ws + (MODE == 0 ? WS_U0 : (MODE == 1 ? WS_OW : WS_OW + 16 * MiB)));
    float* LOGD = (float*)(ws + WS_LOGD) + (size_t)MODE * LA_ITEMS * 256;
    const int hk = (MODE == 1) ? (w >> 2) : 0;
    const int hs = (MODE == 2) ? (w >> 1) : 0;
#pragma unroll 1
    for (int item = item_first; item < LA_ITEMS; item += item_stride) {
        const int sc = item & 15, bh = item >> 4, b = bh >> 2, hx = bh & 3;
        PROF(63);
        f32x16 S[4];
#pragma unroll
        for (int dt = 0; dt < 4; ++dt)
#pragma unroll
            for (int r = 0; r < 16; ++r) S[dt][r] = 0.f;
        if constexpr (PHASE == 1 && SCANNED) { LAUNDER();
            if (sc > 0) { const float* U = Ubase + (size_t)(item - 1) * 32768 + (size_t)w * 4096 + lane;
#pragma unroll
                for (int dt = 0; dt < 4; ++dt)
#pragma unroll
                    for (int r = 0; r < 16; ++r) S[dt][r] = U[(dt * 16 + r) * 64]; }
        }
        if constexpr (PHASE == 1 && !SCANNED) { LAUNDER();
            LAS float* FD = (LAS float*)L;
            __syncthreads();
            for (int e2 = tid; e2 < sc * 256; e2 += NTHR) FD[e2] = __expf(LOGD[(size_t)(bh << 4) * 256 + e2]);
            __syncthreads();
#pragma unroll 2
            for (int sp = 0; sp < sc; ++sp) {
                const float* U = Ubase + (size_t)((bh << 4) + sp) * 32768 + (size_t)w * 4096 + lane;
                float u[64];
#pragma unroll
                for (int k = 0; k < 64; ++k) u[k] = U[k * 64];
#pragma unroll
                for (int dt = 0; dt < 4; ++dt)
#pragma unroll
                    for (int q = 0; q < 4; ++q) {
                        f32x4 f;
                        if constexpr (MODE == 2) { const float fs = FD[sp * 256 + hs]; f = (f32x4){fs, fs, fs, fs}; } else f = *(const LAS f32x4*)(FD + sp * 256 + hk * 128 + 32 * dt + crow(4 * q, h));
#pragma unroll
                        for (int e2 = 0; e2 < 4; ++e2) S[dt][4 * q + e2] = S[dt][4 * q + e2] * f[e2] + u[dt * 16 + 4 * q + e2];
                    }
            }
            __syncthreads();
        }
        { LAUNDER();
        if (tid < 256) ((LAS float*)(L + O_LS))[tid] = 0.f; }
        __syncthreads();
        constexpr int CPR = CL / 8, NVQ = 256 * CPR / NTHR;
        u32x4 kr[2], qr[2], vr[NVQ], ktr[2]; float sg0 = 0.f, sg1 = 0.f, sg2 = 0.f;
        u32x2 gzr[NI][4];
        f32x4 nwr[4];
        (void)gzr; (void)nwr;
#define STG_LOAD(cc_) do { const int c_ = (cc_); const size_t tk = (size_t)b * SEQ + sc * 512 + c_ * CL; const int citem = (b * 4 + hx) * (SEQ / CL) + sc * C::NCH + c_; \
            const bf16_t* ksrc; const bf16_t* qsrc; int ldk; \
            if constexpr (MODE == 0) { ksrc = (const bf16_t*)(act + A0_GK) + tk * 512 + hx * 128; qsrc = (const bf16_t*)(act + A0_GQ) + tk * 512 + hx * 128; ldk = 512; } \
            else if constexpr (MODE == 1) { ksrc = (const bf16_t*)(act + A1_HF) + tk * 1024 + hx * 256; qsrc = (const bf16_t*)(act + A1_HQ) + tk * 1024 + hx * 256; ldk = 1024; } \
            else { ksrc = (const bf16_t*)(ws + WS_U0) + tk * 512 + (hx >> 1) * 128; qsrc = ksrc + 256; ldk = 512; } \
            const bf16_t* vsrc = (MODE == 0) ? (const bf16_t*)(act + A0_GVT) + (size_t)(hx * 256) * MTOK + tk : (MODE == 1) ? (const bf16_t*)(act + A1_HIT) + (size_t)(hx * 256) * MTOK + tk \
                                                                                                              : (const bf16_t*)(ws + WS_OC) + (size_t)(hx * 256) * MTOK + tk; \
            _Pragma("unroll") for (int i = 0; i < 2; ++i) { const int ci = tid + 512 * i, hh2 = (NH == 2) ? (ci >> 9) : 0, j = (ci >> 4) & (CL - 1), cc = ci & 15; \
                if constexpr (PHASE == 1) { kr[i] = *(const u32x4*)(ksrc + (size_t)j * ldk + hh2 * 128 + cc * 8); qr[i] = *(const u32x4*)(qsrc + (size_t)j * ldk + hh2 * 128 + cc * 8); } } \
            { const bf16_t* ktsrc = (MODE == 2) ? (const bf16_t*)(ws + WS_HY + 32 * MiB) + ((tk >> 6) * 2 + (hx >> 1)) * (128 * 64) : (const bf16_t*)(ws + WS_HY) + (size_t)citem * (NH * 128 * CL); \
              _Pragma("unroll") for (int i = 0; i < 2; ++i) ktr[i] = *(const u32x4*)(ktsrc + (size_t)(tid + 512 * i) * 8); } \
            _Pragma("unroll") for (int q = 0; q < NVQ; ++q) { const int ci = q * NTHR + tid, v = ci / CPR, cc = ci % CPR; vr[q] = *(const u32x4*)(vsrc + (size_t)v * MTOK + cc * 8); } \
            if constexpr (MODE == 2) { if (tid < 256) { const size_t gi = (tk + (tid & 63)) * 16 + 4 * hx + (tid >> 6); sg0 = ((const float*)(act + A1_BS))[gi]; sg1 = ((const float*)(act + A1_DTV))[gi]; sg2 = ((const float*)(act + A1_WJ))[gi]; } } \
            else { if (tid < NH * 128) sg0 = ((const float*)(ws + WS_BL))[(size_t)citem * (NH * 128) + tid]; } } while (0)
#define STG_STORE() do { \
            if constexpr (MODE == 2) { if (tid < 256) { const int hh = tid >> 6, j = tid & 63; const float bl = __shfl(sg0, 63); \
                    ((LAS float*)(L + O_BS))[hh * 64 + j] = sg0; ((LAS float*)(L + O_DT))[hh * 64 + j] = sg1; ((LAS float*)(L + O_WJ))[hh * 64 + j] = sg2; \
                    if (j == 0) { ((LAS float*)(L + O_DEC))[hh] = __expf(bl); ((LAS float*)(L + O_LS))[hh] += bl; } } } \
            else { if (tid < NH * 128) { ((LAS float*)(L + O_DEC))[tid] = __expf(sg0); ((LAS float*)(L + O_LS))[tid] += sg0; } } \
            _Pragma("unroll") for (int i = 0; i < 2; ++i) { const int ci = tid + 512 * i, hh2 = (NH == 2) ? (ci >> 9) : 0, j = (ci >> 4) & (CL - 1), cc = ci & 15; \
                if constexpr (PHASE == 1) { *(LAS u32x4*)(L + O_KH + (hh2 * CL + j) * PQ + cc * 16) = kr[i]; *(LAS u32x4*)(L + O_QH + (hh2 * CL + j) * PQ + cc * 16) = qr[i]; } \
                { constexpr int TPR = CL / 8; const int pi = tid + 512 * i, row = pi / TPR, pc = pi % TPR; *(LAS u32x4*)(L + O_KT + row * PJ + pc * 16) = ktr[i]; } } \
            _Pragma("unroll") for (int q = 0; q < NVQ; ++q) { const int ci = q * NTHR + tid, v = ci / CPR, cc = ci % CPR; *(LAS u32x4*)(L + O_VT + v * PJ + cc * 16) = vr[q]; } } while (0)
        PROF(MODE * 20 + PHASE * 10 + 0);
        if constexpr (PHASE == 1 && MODE != 2) { LAUNDER();
#pragma unroll
            for (int q = 0; q < 4; ++q) { const int vv = 32 * w + crow(4 * q, h); nwr[q] = *(const f32x4*)((MODE == 0 ? a.in[10] : a.in[20]) + ((MODE == 0) ? vv : (vv & 127))); } }
        { LAUNDER(); STG_LOAD(0); }
#pragma unroll 1
        for (int c = 0; c < C::NCH; ++c) {
            const int tpos = sc * 512 + c * CL;
            const size_t tok0 = (size_t)b * SEQ + tpos;
            { LAUNDER();
            STG_STORE();
            }
            __syncthreads();
            PROF(MODE * 20 + PHASE * 10 + 1);
            if (c + 1 < C::NCH) { LAUNDER(); STG_LOAD(c + 1); }
            if constexpr (PHASE == 1) { LAUNDER();
                const bf16_t* gbase = (MODE == 0) ? (const bf16_t*)(act + A0_GZ) + hx * 256 : (MODE == 1) ? (const bf16_t*)(act + A1_HZ) + hx * 256 : (const bf16_t*)(act + A1_SZ) + hx * 256;
#pragma unroll
                for (int ni = 0; ni < NI; ++ni)
#pragma unroll
                    for (int q = 0; q < 4; ++q) gzr[ni][q] = *(const u32x2*)(gbase + (tok0 + 32 * ni + r32) * 1024 + 32 * w + crow(4 * q, h)); }
            f32x16 oT[NI];
            if constexpr (PHASE == 1) {
                { LAUNDER();
                if constexpr (MODE == 0 || MODE == 2) {
                    if (w < 3) { const int mj = (w == 2), ni = (w >= 1);
                        f32x16 t;
#pragma unroll
                        for (int r = 0; r < 16; ++r) t[r] = 0.f;
                        { bf16x8 fa[8], fb[8];
                            __builtin_amdgcn_sched_barrier(0);
#pragma unroll
                            for (int s = 0; s < 8; ++s) { fa[s] = *(const LAS bf16x8*)(L + O_KH + (32 * mj + r32) * PQ + (16 * s + 8 * h) * 2); fb[s] = *(const LAS bf16x8*)(L + O_QH + (32 * ni + r32) * PQ + (16 * s + 8 * h) * 2); }
                            __builtin_amdgcn_sched_barrier(0);
                            __builtin_amdgcn_s_setprio(2);
#pragma unroll
                            for (int s = 0; s < 8; ++s) t = MFMA32(fa[s], fb[s], t);
                            __builtin_amdgcn_s_setprio(0);
                            __builtin_amdgcn_sched_barrier(0); }
                        const int i = 32 * ni + r32;
#pragma unroll
                        for (int hh = 0; hh < HA; ++hh) {
                            float bsi = 0.f; if constexpr (MODE == 2) bsi = ((LAS float*)(L + O_BS))[hh * 64 + i];
#pragma unroll
                            for (int q = 0; q < 4; ++q) { float o[4];
#pragma unroll
                                for (int e = 0; e < 4; ++e) { const int j = 32 * mj + crow(4 * q + e, h); float v = t[4 * q + e];
                                    if constexpr (MODE == 2) v *= __expf(fminf(bsi - ((LAS float*)(L + O_BS))[hh * 64 + j], 0.f)) * ((LAS float*)(L + O_DT))[hh * 64 + j];
                                    o[e] = (j <= i) ? v : 0.f; }
                                *(LAS u32x2*)(L + O_ATT + (hh * CL + i) * PJ + (32 * mj + crow(4 * q, h)) * 2) = (u32x2){pk2(o[0], o[1]), pk2(o[2], o[3])}; } }
                    }
                } else {
                    if (w < 2) { f32x16 t;
#pragma unroll
                        for (int r = 0; r < 16; ++r) t[r] = 0.f;
                        { bf16x8 fa[8], fb[8];
                            __builtin_amdgcn_sched_barrier(0);
#pragma unroll
                            for (int s = 0; s < 8; ++s) { fa[s] = *(const LAS bf16x8*)(L + O_KH + (w * CL + r32) * PQ + (16 * s + 8 * h) * 2); fb[s] = *(const LAS bf16x8*)(L + O_QH + (w * CL + r32) * PQ + (16 * s + 8 * h) * 2); }
                            __builtin_amdgcn_sched_barrier(0);
                            __builtin_amdgcn_s_setprio(2);
#pragma unroll
                            for (int s = 0; s < 8; ++s) t = MFMA32(fa[s], fb[s], t);
                            __builtin_amdgcn_s_setprio(0);
                            __builtin_amdgcn_sched_barrier(0); }
#pragma unroll
                        for (int q = 0; q < 4; ++q) { float o[4];
#pragma unroll
                            for (int e = 0; e < 4; ++e) { const int j = crow(4 * q + e, h); o[e] = (j <= r32) ? t[4 * q + e] : 0.f; }
                            *(LAS u32x2*)(L + O_ATT + (w * CL + r32) * PJ + crow(4 * q, h) * 2) = (u32x2){pk2(o[0], o[1]), pk2(o[2], o[3])}; }
                    }
                }
                }
                { LAUNDER();
#pragma unroll
                for (int ni = 0; ni < NI; ++ni) {
#pragma unroll
                    for (int r = 0; r < 16; ++r) oT[ni][r] = 0.f;
                    bf16x8 fb[8];
                    __builtin_amdgcn_sched_barrier(0);
#pragma unroll
                    for (int ds = 0; ds < 8; ++ds) { const LAS unsigned char* qp = L + O_QH + (hk * CL + 32 * ni + r32) * PQ + (16 * ds + 4 * h) * 2;
                        const u32x2 lo = *(const LAS u32x2*)qp, hi = *(const LAS u32x2*)(qp + 16); fb[ds] = __builtin_bit_cast(bf16x8, (u32x4){lo.x, lo.y, hi.x, hi.y}); }
                    __builtin_amdgcn_sched_barrier(0);
#pragma unroll
                    for (int ds = 0; ds < 8; ++ds) { const int dt = ds >> 1, s = ds & 1; u32x4 p;
#pragma unroll
                        for (int e = 0; e < 4; ++e) p[e] = pk2(S[dt][8 * s + 2 * e], S[dt][8 * s + 2 * e + 1]);
                        oT[ni] = MFMA32(__builtin_bit_cast(bf16x8, p), fb[ds], oT[ni]); }
                    __builtin_amdgcn_sched_barrier(0);
                    if constexpr (MODE == 2) { const float e = __expf(((LAS float*)(L + O_BS))[hs * 64 + 32 * ni + r32]);
#pragma unroll
                        for (int r = 0; r < 16; ++r) oT[ni][r] *= e; }
                }
                }
                __syncthreads();
                PROF(MODE * 20 + PHASE * 10 + 2);
                { LAUNDER();
                const int ha = (MODE == 0) ? 0 : (MODE == 1 ? (w >> 2) : (w >> 1));
#pragma unroll
                for (int ni = 0; ni < NI; ++ni) { bf16x8 fa[2 * (NI)], fb[2 * (NI)];
                    __builtin_amdgcn_sched_barrier(0);
#pragma unroll
                    for (int s = 0; s < 2 * (ni + 1); ++s) { fa[s] = *(const LAS bf16x8*)(L + O_VT + (32 * w + r32) * PJ + (16 * s + 8 * h) * 2);
                        fb[s] = *(const LAS bf16x8*)(L + O_ATT + (ha * CL + 32 * ni + r32) * PJ + (16 * s + 8 * h) * 2); }
                    __builtin_amdgcn_sched_barrier(0);
                    __builtin_amdgcn_s_setprio(2);
#pragma unroll
                    for (int s = 0; s < 2 * (ni + 1); ++s) oT[ni] = MFMA32(fa[s], fb[s], oT[ni]);
                    __builtin_amdgcn_s_setprio(0);
                    __builtin_amdgcn_sched_barrier(0); }
                }
            }
            PROF(MODE * 20 + PHASE * 10 + 3);
            { LAUNDER();
            if constexpr (MODE == 2) { const float dsc = ((LAS float*)(L + O_DEC))[hs];
#pragma unroll
                for (int dt = 0; dt < 4; ++dt)
#pragma unroll
                    for (int r = 0; r < 16; ++r) S[dt][r] *= dsc; }
#pragma unroll
            for (int s = 0; s < CL / 16; ++s) { bf16x8 B, A[4]; float wj[8];
                __builtin_amdgcn_sched_barrier(0);
                B = *(const LAS bf16x8*)(L + O_VT + (32 * w + r32) * PJ + (16 * s + 8 * h) * 2);
#pragma unroll
                for (int dt = 0; dt < 4; ++dt) A[dt] = *(const LAS bf16x8*)(L + O_KT + (hk * 128 + 32 * dt + r32) * PJ + (16 * s + 8 * h) * 2);
                if constexpr (MODE == 2) { const f32x4 wa = *(const LAS f32x4*)(L + O_WJ + (hs * 64 + 16 * s + 8 * h) * 4), wb = *(const LAS f32x4*)(L + O_WJ + (hs * 64 + 16 * s + 8 * h + 4) * 4);
#pragma unroll
                    for (int e = 0; e < 4; ++e) { wj[e] = wa[e]; wj[4 + e] = wb[e]; } }
                __builtin_amdgcn_sched_barrier(0);
#pragma unroll
                for (int dt = 0; dt < 4; ++dt) {
                    if constexpr (MODE == 2) { const u32x4 ap = __builtin_bit_cast(u32x4, A[dt]); u32x4 o;
#pragma unroll
                        for (int e = 0; e < 4; ++e) o[e] = pk2(bflo(ap[e]) * wj[2 * e], bfhi(ap[e]) * wj[2 * e + 1]);
                        A[dt] = __builtin_bit_cast(bf16x8, o); }
                    S[dt] = MFMA32(A[dt], B, S[dt]); }
                __builtin_amdgcn_sched_barrier(0); }
            if constexpr (MODE != 2) {
#pragma unroll
                for (int dt = 0; dt < 4; ++dt)
#pragma unroll
                    for (int q = 0; q < 4; ++q) { const f32x4 f = *(const LAS f32x4*)(L + O_DEC + (hk * 128 + 32 * dt + crow(4 * q, h)) * 4);
#pragma unroll
                        for (int e = 0; e < 4; ++e) S[dt][4 * q + e] *= f[e]; } }
            }
            PROF(MODE * 20 + PHASE * 10 + 4);
            if constexpr (PHASE == 1) { LAUNDER();
                float part[NI];
                if constexpr (MODE == 2) {
                    const int head = 4 * hx + hs; const float Dh = a.in[25][head];
#pragma unroll
                    for (int ni = 0; ni < NI; ++ni) { const int i = 32 * ni + r32; const size_t tok = tok0 + i; float ss = 0.f;
#pragma unroll
                        for (int q = 0; q < 4; ++q) { const int vv = 32 * w + crow(4 * q, h);
                            const u32x2 zz = gzr[ni][q];
                            const float zf[4] = {bflo(zz.x), bfhi(zz.x), bflo(zz.y), bfhi(zz.y)}; float o[4];
#pragma unroll
                            for (int e = 0; e < 4; ++e) { const float xs = bf2f(*(const LAS unsigned short*)(L + O_VT + (vv + e) * PJ + i * 2));
                                o[e] = (oT[ni][4 * q + e] + Dh * xs) * silu_fast(zf[e]); ss += o[e] * o[e]; }
                            *(u32x2*)((bf16_t*)(ws + WS_CONCAT) + tok * 2048 + hx * 256 + vv) = (u32x2){pk2(o[0], o[1]), pk2(o[2], o[3])}; }
                        ss = half_sum(ss); part[ni] = ss;
                        if (h == 0) ((LAS float*)(L + O_RED))[w * 64 + i] = ss; }
                    __syncthreads();
                    if ((w & 1) == 0 && h == 0) {
#pragma unroll
                        for (int ni = 0; ni < NI; ++ni) { const int i = 32 * ni + r32; ((float*)(ws + WS_SSQ))[(tok0 + i) * 16 + head] = part[ni] + ((LAS float*)(L + O_RED))[(w + 1) * 64 + i]; } }
                } else {
#pragma unroll
                    for (int ni = 0; ni < NI; ++ni) { float ss = 0.f;
#pragma unroll
                        for (int r = 0; r < 16; ++r) ss += oT[ni][r] * oT[ni][r];
                        ss = half_sum(ss); if (h == 0) ((LAS float*)(L + O_RED))[w * 64 + 32 * ni + r32] = ss; }
                    __syncthreads();
#pragma unroll
                    for (int ni = 0; ni < NI; ++ni) { const int i = 32 * ni + r32; const size_t tok = tok0 + i; float tot = 0.f;
                        if constexpr (MODE == 0) {
#pragma unroll
                            for (int ww = 0; ww < 8; ++ww) tot += ((LAS float*)(L + O_RED))[ww * 64 + i];
                        } else {
#pragma unroll
                            for (int ww = 0; ww < 4; ++ww) tot += ((LAS float*)(L + O_RED))[((w & 4) + ww) * 64 + i];
                        }
                        const float rs = __builtin_amdgcn_rsqf(tot * (MODE == 0 ? 1.0f / 256.0f : 1.0f / 128.0f) + EPS);
#pragma unroll
                        for (int q = 0; q < 4; ++q) {
                            const int vv = 32 * w + crow(4 * q, h);
                            const u32x2 zz = gzr[ni][q]; const float zf[4] = {bflo(zz.x), bfhi(zz.x), bflo(zz.y), bfhi(zz.y)}; float o[4];
#pragma unroll
                            for (int e = 0; e < 4; ++e) o[e] = oT[ni][4 * q + e] * rs * nwr[q][e] * silu_fast(zf[e]);
                            bf16_t* dst = (bf16_t*)(ws + WS_CONCAT) + tok * 2048 + (MODE == 0 ? 0 : 1024) + hx * 256 + vv;
                            *(u32x2*)dst = (u32x2){pk2(o[0], o[1]), pk2(o[2], o[3])}; } }
                }
            }
            __syncthreads();
            PROF(MODE * 20 + PHASE * 10 + 5);
        }
        if constexpr (PHASE == 0) { LAUNDER();
            float* U = Ubase + (size_t)item * 32768 + (size_t)w * 4096 + lane;
#pragma unroll
            for (int dt = 0; dt < 4; ++dt)
#pragma unroll
                for (int r = 0; r < 16; ++r) U[(dt * 16 + r) * 64] = S[dt][r];
            if (tid < 256) LOGD[(size_t)item * 256 + tid] = ((LAS float*)(L + O_LS))[tid];
        }
        __syncthreads();
    }
}
#undef LAUNDER
#undef STG_LOAD
#undef STG_STORE

template <int MODE> DI void la_scan_item(const Frame& F, CArgs& a, int bh, int ws_) {
    unsigned char* ws = a.ws;
    float* Ubase = (float*)(ws + (MODE == 1 ? WS_OW : WS_OW + 16 * MiB));
    const float* LOGD = (const float*)(ws + WS_LOGD) + (size_t)MODE * LA_ITEMS * 256;
    const int lane = F.lane, h = lane >> 5, rw = F.wave;
    float s[8];
#pragma unroll
    for (int k = 0; k < 8; ++k) s[k] = 0.f;
#pragma unroll 1
    for (int half8 = 0; half8 < 2; ++half8) {
        float u[8][8], f[8][8];
#pragma unroll
        for (int i = 0; i < 8; ++i) { const int sc = half8 * 8 + i;
            const float* U = Ubase + (size_t)((bh << 4) + sc) * 32768 + (size_t)ws_ * 4096 + lane; const float* ld = LOGD + (size_t)((bh << 4) + sc) * 256;
#pragma unroll
            for (int k = 0; k < 8; ++k) { const int reg = 8 * rw + k, dt = reg >> 4, r = reg & 15; u[i][k] = U[reg * 64];
                f[i][k] = (MODE == 2) ? ld[ws_ >> 1] : ld[(ws_ >> 2) * 128 + 32 * dt + crow(r, h)]; } }
#pragma unroll
        for (int i = 0; i < 8; ++i) { const int sc = half8 * 8 + i; float* U = Ubase + (size_t)((bh << 4) + sc) * 32768 + (size_t)ws_ * 4096 + lane;
#pragma unroll
            for (int k = 0; k < 8; ++k) { s[k] = s[k] * __expf(f[i][k]) + u[i][k]; U[(8 * rw + k) * 64] = s[k]; } }
    }
}
constexpr int NSA_KP = 272, NSA_VP = 144;
constexpr int NL_K = 0, NL_V = NL_K + 64 * NSA_KP, NL_BUF = NL_V + 128 * NSA_VP  , NL_IMP = 2 * NL_BUF, NL_SEL = NL_IMP + 2 * 8 * 8 * 132 * 4, NL_QI = NL_SEL + 64 * 16, NL_END = NL_QI + 64;
static_assert(NL_END <= RING_BYTES, "NSA LDS");
constexpr float NEG_BIG = -1e30f;

struct NsaTile { u32x4 k0, k1, v0, v1; };
DI void nsa_tile_load(NsaTile& T, const bf16_t* Kg  , const bf16_t* Vg  , int ldv, int t, int tid) {
    const int c0 = tid, c1 = tid + 512;
    T.k0 = *(const u32x4*)(Kg + (size_t)(64 * t + (c0 >> 4)) * 128 + (c0 & 15) * 8);
    T.k1 = *(const u32x4*)(Kg + (size_t)(64 * t + (c1 >> 4)) * 128 + (c1 & 15) * 8);
    T.v0 = *(const u32x4*)(Vg + (size_t)(c0 >> 3) * ldv + 64 * t + (c0 & 7) * 8);
    T.v1 = *(const u32x4*)(Vg + (size_t)(c1 >> 3) * ldv + 64 * t + (c1 & 7) * 8);
}
DI void nsa_tile_store(const NsaTile& T, LAS unsigned char* L  , int tid) {
    const int c0 = tid, c1 = tid + 512;
    *(LAS u32x4*)(L + NL_K + (c0 >> 4) * NSA_KP + (c0 & 15) * 16) = T.k0;
    *(LAS u32x4*)(L + NL_K + (c1 >> 4) * NSA_KP + (c1 & 15) * 16) = T.k1;
    { const int cc = c0 & 7; LAS unsigned char* p = L + NL_V + (c0 >> 3) * NSA_VP + (cc >> 1) * 32 + (cc & 1) * 8;
        *(LAS u32x2*)p = (u32x2){T.v0.x, T.v0.y}; *(LAS u32x2*)(p + 16) = (u32x2){T.v0.z, T.v0.w}; }
    { const int cc = c1 & 7; LAS unsigned char* p = L + NL_V + (c1 >> 3) * NSA_VP + (cc >> 1) * 32 + (cc & 1) * 8;
        *(LAS u32x2*)p = (u32x2){T.v1.x, T.v1.y}; *(LAS u32x2*)(p + 16) = (u32x2){T.v1.z, T.v1.w}; }
}
DI void nsa_scores(f32x16 (&sT)[2], const bf16x8 (&qf)[8], LAS unsigned char* L, int r32, int h) {
#pragma unroll
    for (int mt = 0; mt < 2; ++mt) {
#pragma unroll
        for (int r = 0; r < 16; ++r) sT[mt][r] = 0.f;
#pragma unroll
        for (int s = 0; s < 8; ++s) { const bf16x8 A = *(const LAS bf16x8*)(L + NL_K + (32 * mt + r32) * NSA_KP + (16 * s + 8 * h) * 2); sT[mt] = MFMA32(A, qf[s], sT[mt]); }
    }
}
struct NsaState { f32x16 O[4]; float m, l; };
template <int BR> DI bool nsa_valid(int kk  , int tq  , int t, int qb, bool lane_sel) {
    if constexpr (BR == 0) return (16 * kk + 31 <= tq) && (kk <= 510);
    else if constexpr (BR == 1) return lane_sel && (kk <= tq);
    else return (kk <= tq) && (kk > tq - 512);
}
constexpr float NSA_THR = 10.0f;
DI bf16x8 nsa_ldk(LAS unsigned char* L, int mt, int s, int r32, int h) { return *(const LAS bf16x8*)(L + NL_K + (32 * mt + r32) * NSA_KP + (16 * s + 8 * h) * 2); }
DI bf16x8 nsa_ldv(LAS unsigned char* L, int dt, int g  , int r32, int h) {
    return *(const LAS bf16x8*)(L + NL_V + (32 * dt + r32) * NSA_VP + (16 * g + 8 * h) * 2);
}
template <int BR> DI void nsa_tile_compute(NsaState& st, const bf16x8 (&qf)[8], LAS unsigned char* L, int t, int tq, bool lane_sel, bool edge, int r32, int h) {
    f32x16 sT[2];
    const float nm = (BR == 1 && !lane_sel) ? NEG_BIG : -st.m;
#pragma unroll
    for (int mt = 0; mt < 2; ++mt)
#pragma unroll
        for (int r = 0; r < 16; ++r) sT[mt][r] = nm;
    bf16x8 ka[8], kb[8];
    __builtin_amdgcn_sched_barrier(0);
#pragma unroll
    for (int s = 0; s < 8; ++s) ka[s] = nsa_ldk(L, 0, s, r32, h);
    __builtin_amdgcn_sched_barrier(0);
    __builtin_amdgcn_s_setprio(2);
#pragma unroll
    for (int s = 0; s < 8; ++s) { kb[s] = nsa_ldk(L, 1, s, r32, h); sT[0] = MFMA32(ka[s], qf[s], sT[0]); }
    __builtin_amdgcn_sched_barrier(0);
    bf16x8 va[4], vb[4];
#pragma unroll
    for (int s = 0; s < 8; ++s) { if (s < 4) va[s] = nsa_ldv(L, s, 0, r32, h); sT[1] = MFMA32(kb[s], qf[s], sT[1]); }
    __builtin_amdgcn_s_setprio(0);
    __builtin_amdgcn_sched_barrier(0);
    if (edge) {
#pragma unroll
        for (int mt = 0; mt < 2; ++mt)
#pragma unroll
            for (int r = 0; r < 16; ++r) { const int kk = 64 * t + 32 * mt + crow(r, h); const bool ok = nsa_valid<BR>(kk, tq, t, 0, true); sT[mt][r] = ok ? sT[mt][r] : NEG_BIG; }
    }
    float rm = fmaxf(sT[0][0], sT[1][0]);
#pragma unroll
    for (int r = 1; r < 16; ++r) rm = fmaxf(rm, fmaxf(sT[0][r], sT[1][r]));
    if (__any(rm > NSA_THR)) {
        rm = half_max(rm);
        const float dl = fmaxf(rm, 0.f), alpha = fast_exp2(-dl);
        st.m += dl; st.l *= alpha;
#pragma unroll
        for (int mt = 0; mt < 2; ++mt)
#pragma unroll
            for (int r = 0; r < 16; ++r) sT[mt][r] -= dl;
#pragma unroll
        for (int dt = 0; dt < 4; ++dt)
#pragma unroll
            for (int r = 0; r < 16; ++r) st.O[dt][r] *= alpha;
    }
    float ps = 0.f;
#pragma unroll
    for (int g = 0; g < 4; ++g) { const int mt = g >> 1, s = g & 1; u32x4 pk;
#pragma unroll
        for (int e = 0; e < 4; ++e) { unsigned w = pk2(fast_exp2(sT[mt][8 * s + 2 * e]), fast_exp2(sT[mt][8 * s + 2 * e + 1]));
            ps = __builtin_amdgcn_fdot2_f32_bf16(__builtin_bit_cast(bf16x2_t, w), __builtin_bit_cast(bf16x2_t, 0x3f803f80u), ps, false);
            pk[e] = w; }
        const bf16x8 B = __builtin_bit_cast(bf16x8, pk);
        __builtin_amdgcn_sched_barrier(0);
        __builtin_amdgcn_s_setprio(2);
        if ((g & 1) == 0) {
#pragma unroll
            for (int dt = 0; dt < 4; ++dt) { vb[dt] = nsa_ldv(L, dt, g + 1, r32, h); st.O[dt] = MFMA32(va[dt], B, st.O[dt]); }
        } else {
#pragma unroll
            for (int dt = 0; dt < 4; ++dt) { if (g < 3) va[dt] = nsa_ldv(L, dt, g + 1, r32, h); st.O[dt] = MFMA32(vb[dt], B, st.O[dt]); }
        }
        __builtin_amdgcn_s_setprio(0);
        __builtin_amdgcn_sched_barrier(0);
    }
    st.l += ps;
}
template <int BR> DI void nsa_branch(NsaState& st, const bf16x8 (&qf)[8], LAS unsigned char* L, const bf16_t* Kg, const bf16_t* Vg, int ldv, int t_lo, int t_hi, int qb, int tq, const u32x4& selw, int tid0) {
#pragma unroll
    for (int dt = 0; dt < 4; ++dt)
#pragma unroll
        for (int r = 0; r < 16; ++r) st.O[dt][r] = 0.f;
    st.m = 0.f; st.l = 0.f;
    NsaTile T;
    { int tid = tid0; asm volatile("" : "+v"(tid)); nsa_tile_load(T, Kg, Vg, ldv, t_lo, tid);
        __syncthreads();
        nsa_tile_store(T, L + (t_lo & 1) * NL_BUF, tid);
        if (t_lo < t_hi) nsa_tile_load(T, Kg, Vg, ldv, t_lo + 1, tid);
        __syncthreads(); }
#pragma unroll 1
    for (int t = t_lo; t <= t_hi; ++t) {
        int tid = tid0; asm volatile("" : "+v"(tid)); const int lane = tid & 63, r32 = lane & 31, h = lane >> 5;
        if (t < t_hi) nsa_tile_store(T, L + ((t + 1) & 1) * NL_BUF, tid);
        if (t + 1 < t_hi) nsa_tile_load(T, Kg, Vg, ldv, t + 2, tid);
        bool lane_sel = true, edge;
        if constexpr (BR == 0) edge = (1024 * t + 1039 > 64 * qb) || (t == 7);
        else if constexpr (BR == 1) { edge = (t == qb); const unsigned wsel = (t < 32) ? selw.x : (t < 64) ? selw.y : (t < 96) ? selw.z : selw.w; lane_sel = (wsel >> (t & 31)) & 1u; }
        else edge = (t == qb) || (t + 8 == qb);
        if (BR != 1 || __any(lane_sel)) nsa_tile_compute<BR>(st, qf, L + (t & 1) * NL_BUF, t, tq, lane_sel, edge, r32, h);
        __syncthreads();
    }
}
DI void nsa_flush_native(const NsaState& st, bf16_t* OWN, int item, float gate, int tid) {
    float lt = half_sum(st.l);
    const float sc = (lt > 0.f) ? gate / lt : 0.f;
    u32x2* base = (u32x2*)OWN + (size_t)item * 16 * 512 + tid;
#pragma unroll
    for (int dt = 0; dt < 4; ++dt)
#pragma unroll
        for (int q = 0; q < 4; ++q) base[(dt * 4 + q) * 512] = (u32x2){pk2(st.O[dt][4 * q] * sc, st.O[dt][4 * q + 1] * sc), pk2(st.O[dt][4 * q + 2] * sc, st.O[dt][4 * q + 3] * sc)};
}
template <int RMW> DI void nsa_flush(const NsaState& st, bf16_t* OW, size_t tok, int head, float gate, int lane) {
    const int h = lane >> 5;
    float lt = half_sum(st.l);
    const float sc = (lt > 0.f) ? gate / lt : 0.f;
#pragma unroll
    for (int dt = 0; dt < 4; ++dt)
#pragma unroll
        for (int q = 0; q < 4; ++q) { bf16_t* p = OW + tok * 1024 + head * 128 + 32 * dt + crow(4 * q, h);
            float o[4];
#pragma unroll
            for (int e = 0; e < 4; ++e) o[e] = st.O[dt][4 * q + e] * sc;
            if constexpr (RMW) { const u32x2 old = *(const u32x2*)p; o[0] += bflo(old.x); o[1] += bfhi(old.x); o[2] += bflo(old.y); o[3] += bfhi(old.y); }
            *(u32x2*)p = (u32x2){pk2(o[0], o[1]), pk2(o[2], o[3])}; }
}
DI void nsa_load_q(bf16x8 (&qf)[8], const bf16_t* NQ, size_t tok, int head, int h) {
#pragma unroll
    for (int s = 0; s < 8; ++s) qf[s] = *(const bf16x8*)(NQ + tok * 1024 + head * 128 + 16 * s + 8 * h);
}
DI void nsa_win_item(const Frame& F, CArgs& a, int item) {
    unsigned char* act = a.ws + WS_ACT; LAS unsigned char* L = F.lds;
    const int qb = item >> 2, bg = item & 3, b = bg >> 1, g = bg & 1;
    const int lane = F.lane, r32 = lane & 31, h = lane >> 5, w = F.wave;
    const int ti = 8 * w + (r32 >> 2), j = r32 & 3, head = g * 4 + j, tq = 64 * qb + ti; const size_t tok = (size_t)b * SEQ + tq;
    bf16x8 qf[8]; nsa_load_q(qf, (const bf16_t*)(act + A0_NQ), tok, head, h);
    NsaState st; const u32x4 nosel = {0u, 0u, 0u, 0u};
    nsa_branch<2>(st, qf, L, (const bf16_t*)(act + A0_NKW) + (size_t)bg * SEQ * 128, (const bf16_t*)(act + A0_NVWT) + (size_t)bg * 128 * SEQ, SEQ, qb >= 8 ? qb - 8 : 0, qb, qb, tq, nosel, F.tid);
    const float gate = ((const float*)(act + A0_NGATE))[tok * 24 + head * 3 + 2];
    nsa_flush_native(st, (bf16_t*)(a.ws + WS_OW), item, gate, F.tid);
}
DI void nsa_main_item(const Frame& F, CArgs& a, int item) {
    unsigned char* act = a.ws + WS_ACT; LAS unsigned char* L = F.lds;
    const int qb = item >> 2, bg = item & 3, b = bg >> 1, g = bg & 1;
    const int lane = F.lane, r32 = lane & 31, h = lane >> 5, w = F.wave;
    const int ti = 8 * w + (r32 >> 2), j = r32 & 3, head = g * 4 + j, tq = 64 * qb + ti; const size_t tok = (size_t)b * SEQ + tq;
    PROF(63);
    bf16x8 qf[8]; nsa_load_q(qf, (const bf16_t*)(act + A0_NQ), tok, head, h);
    const bf16_t* KC = (const bf16_t*)(a.ws + WS_KC) + (size_t)bg * 512 * 128; const bf16_t* VCT = (const bf16_t*)(a.ws + WS_VCT) + (size_t)bg * 128 * 512;
    const float* gates = (const float*)(act + A0_NGATE) + tok * 24 + head * 3;
    NsaState st; const u32x4 nosel = {0u, 0u, 0u, 0u};
    const int tc_hi = (4 * qb + 2) >> 6;
    nsa_branch<0>(st, qf, L, KC, VCT, 512, 0, tc_hi, qb, tq, nosel, F.tid);
    PROF(70);
    nsa_flush_native(st, (bf16_t*)(a.ws + WS_OC), item, gates[0], F.tid);
    LAS float* IMP = (LAS float*)(L + NL_IMP) + w * 2 * 8 * 132;
    LAS unsigned* SEL = (LAS unsigned*)(L + NL_SEL);
    u32x4 selw;
    if (qb >= 16) {
        const float lt = half_sum(st.l); const float mfin = st.m + (lt > 0.f ? __log2f(lt) : 1e30f);
        for (int e = lane; e < 2 * 8 * 132; e += 64) IMP[e] = 0.f;
        u32x4 kt0, kt1;
#define IMP_KLOAD(t_) do { const int c0_ = tidl, c1_ = tidl + 512; kt0 = *(const u32x4*)(KC + (size_t)(64 * (t_) + (c0_ >> 4)) * 128 + (c0_ & 15) * 8); kt1 = *(const u32x4*)(KC + (size_t)(64 * (t_) + (c1_ >> 4)) * 128 + (c1_ & 15) * 8); } while (0)
#define IMP_KSTORE(b_) do { const int c0_ = tidl, c1_ = tidl + 512; LAS unsigned char* lb_ = L + (b_) * NL_BUF; *(LAS u32x4*)(lb_ + NL_K + (c0_ >> 4) * NSA_KP + (c0_ & 15) * 16) = kt0; *(LAS u32x4*)(lb_ + NL_K + (c1_ >> 4) * NSA_KP + (c1_ & 15) * 16) = kt1; } while (0)
        { int tidl = F.tid; asm volatile("" : "+v"(tidl));
            IMP_KLOAD(0);
            __syncthreads();
            IMP_KSTORE(0); if (0 < tc_hi) IMP_KLOAD(1);
            __syncthreads(); }
#pragma unroll 1
        for (int t = 0; t <= tc_hi; ++t) {
            int tidl = F.tid; asm volatile("" : "+v"(tidl)); const int lane = tidl & 63, r32 = lane & 31, h = lane >> 5, j = r32 & 3;
            if (t < tc_hi) IMP_KSTORE((t + 1) & 1);
            if (t + 1 < tc_hi) IMP_KLOAD(t + 2);
            f32x16 sT[2]; nsa_scores(sT, qf, L + (t & 1) * NL_BUF, r32, h);
            const bool full = (t < 7) && (16 * (64 * t + 63) + 31 <= 64 * qb + 8 * w);
            if (!full) {
#pragma unroll
                for (int mt = 0; mt < 2; ++mt)
#pragma unroll
                    for (int r = 0; r < 16; ++r) { const int n = 64 * t + 32 * mt + crow(r, h); const bool ok = (16 * n + 31 <= tq) && (n <= 510); sT[mt][r] = ok ? sT[mt][r] : -1e30f; }
            }
#pragma unroll
            for (int mt = 0; mt < 2; ++mt)
#pragma unroll
                for (int q = 0; q < 4; ++q) { float p[4];
#pragma unroll
                    for (int e = 0; e < 4; ++e) p[e] = fast_exp2(sT[mt][4 * q + e] - mfin);
                    float qs = (p[0] + p[1]) + (p[2] + p[3]), p3 = p[3];
                    qs = quad_sum(qs); p3 = quad_sum(p3);
                    const int ablk = 16 * t + 8 * mt + 2 * q + h;
                    if (j == 0) { IMP[(r32 >> 2) * 132 + ablk] = qs; IMP[8 * 132 + (r32 >> 2) * 132 + ablk + 1] = p3; } }
            __syncthreads();
        }
#undef IMP_KLOAD
#undef IMP_KSTORE
        PROF(71);
        { int tidl = F.tid; asm volatile("" : "+v"(tidl)); const int lane = tidl & 63; const int tl = lane >> 3, sub = lane & 7;
            unsigned key[16];
#pragma unroll
            for (int u = 0; u < 16; ++u) { const int s = 1 + sub + 8 * u; const int sx = (s < 128 ? s : 127); const float v = IMP[tl * 132 + sx] + IMP[8 * 132 + tl * 132 + sx];
                key[u] = (s <= qb - 2) ? ((__float_as_uint(v) & ~127u) | (unsigned)(127 - s)) + 128u : 0u; }
            unsigned pre = 0u; bool done = false;
#pragma unroll 1
            for (int bit = 30; bit >= 0; --bit) { const unsigned trial = pre | (1u << bit); int c = 0;
#pragma unroll
                for (int u = 0; u < 16; ++u) c += (key[u] >= trial) ? 1 : 0;
                c = oct_sum(c);
                if (!done && c >= 13) { pre = trial; done = (c == 13); }
                if (__all(done)) break; }
            unsigned m0 = 0u, m1 = 0u, m2 = 0u, m3 = 0u;
#pragma unroll
            for (int u = 0; u < 16; ++u) { const int s = 1 + sub + 8 * u; if (key[u] >= pre && key[u] != 0u) { const unsigned bitv = 1u << (s & 31);
                    if (s < 32) m0 |= bitv; else if (s < 64) m1 |= bitv; else if (s < 96) m2 |= bitv; else m3 |= bitv; } }
            m0 = oct_or(m0); m1 = oct_or(m1); m2 = oct_or(m2); m3 = oct_or(m3);
            m0 |= 1u;
            { const int s1 = qb, s2 = qb - 1; const unsigned b1 = 1u << (s1 & 31), b2 = 1u << (s2 & 31);
                if (s1 < 32) m0 |= b1; else if (s1 < 64) m1 |= b1; else if (s1 < 96) m2 |= b1; else m3 |= b1;
                if (s2 < 32) m0 |= b2; else if (s2 < 64) m1 |= b2; else if (s2 < 96) m2 |= b2; else m3 |= b2; }
            if (sub == 0) { SEL[(8 * w + tl) * 4 + 0] = m0; SEL[(8 * w + tl) * 4 + 1] = m1; SEL[(8 * w + tl) * 4 + 2] = m2; SEL[(8 * w + tl) * 4 + 3] = m3; }
        }
        __syncthreads();
        PROF(72);
        selw = *(LAS u32x4*)(SEL + ti * 4);
    } else {
        selw = (u32x4){0xffffffffu, 0xffffffffu, 0xffffffffu, 0xffffffffu};
    }
    nsa_branch<1>(st, qf, L, (const bf16_t*)(act + A0_NKS) + (size_t)bg * SEQ * 128, (const bf16_t*)(act + A0_NVST) + (size_t)bg * 128 * SEQ, SEQ, 0, qb, qb, tq, selw, F.tid);
    PROF(73);
    { float lt = half_sum(st.l); const float sc = (lt > 0.f) ? gates[1] / lt : 0.f;
        const u32x2* OWN = (const u32x2*)(a.ws + WS_OW) + (size_t)item * 16 * 512 + F.tid; const u32x2* OCN = (const u32x2*)(a.ws + WS_OC) + (size_t)item * 16 * 512 + F.tid;
        LAS unsigned char* TL = L + (32 * w) * 272;
        const int rl0 = lane >> 4, piece = lane & 15;
        const size_t tokw = (size_t)b * SEQ + 64 * qb + 8 * w;
        u32x4 zv[8];
        __builtin_amdgcn_sched_barrier(0);
#pragma unroll
        for (int i = 0; i < 8; ++i) { const int rl = 4 * i + rl0; zv[i] = *(const u32x4*)((const bf16_t*)(act + A0_NZ) + (tokw + (rl >> 2)) * 1024 + (g * 4 + (rl & 3)) * 128 + piece * 8); }
        u32x2 ow[4][4], oc[4][4];
#pragma unroll
        for (int dt = 0; dt < 4; ++dt)
#pragma unroll
            for (int q = 0; q < 4; ++q) { ow[dt][q] = OWN[(dt * 4 + q) * 512]; oc[dt][q] = OCN[(dt * 4 + q) * 512]; }
        __builtin_amdgcn_sched_barrier(0);
#pragma unroll
        for (int i = 0; i < 8; ++i) { const int rl = 4 * i + rl0; *(LAS u32x4*)(TL + rl * 272 + piece * 16) = zv[i]; }
        asm volatile("s_waitcnt lgkmcnt(0)" ::: "memory");
#pragma unroll
        for (int dt = 0; dt < 4; ++dt)
#pragma unroll
            for (int q = 0; q < 4; ++q) { const int d0 = 32 * dt + crow(4 * q, h); const u32x2 a1 = ow[dt][q], a2 = oc[dt][q]; LAS u32x2* zp = (LAS u32x2*)(TL + r32 * 272 + d0 * 2); const u32x2 z = *zp;
                const float o0 = (st.O[dt][4 * q + 0] * sc + bflo(a1.x) + bflo(a2.x)) * silu_fast(bflo(z.x)), o1 = (st.O[dt][4 * q + 1] * sc + bfhi(a1.x) + bfhi(a2.x)) * silu_fast(bfhi(z.x));
                const float o2 = (st.O[dt][4 * q + 2] * sc + bflo(a1.y) + bflo(a2.y)) * silu_fast(bflo(z.y)), o3 = (st.O[dt][4 * q + 3] * sc + bfhi(a1.y) + bfhi(a2.y)) * silu_fast(bfhi(z.y));
                *zp = (u32x2){pk2(o0, o1), pk2(o2, o3)}; }
        asm volatile("s_waitcnt lgkmcnt(0)" ::: "memory");
#pragma unroll
        for (int i = 0; i < 8; ++i) { const int rl = 4 * i + rl0; const u32x4 v = *(const LAS u32x4*)(TL + rl * 272 + piece * 16);
            *(u32x4*)((bf16_t*)(a.ws + WS_CONCAT) + (tokw + (rl >> 2)) * 2048 + 1024 + (g * 4 + (rl & 3)) * 128 + piece * 8) = v; } }
    __syncthreads();
    PROF(74);
    if (F.bid == PROF_BID && F.tid == 0) ((unsigned long long*)(a.ws + 32768))[75] += 100ull * (unsigned)(qb + 1);
}
DI void nsa_compress_finish_item(const Frame& F, CArgs& a, int it) {
    LAS float* HID = (LAS float*)F.lds;
    LAS float* B1 = (LAS float*)(F.lds + 33024);
    LAS float* RED = (LAS float*)(F.lds + 34048);
    const float* P = (const float*)(a.ws + WS_CONCAT);
    const int job = it >> 6, r0 = (it & 63) * 32;
    __syncthreads();
    if (F.tid < 256) { float s = 0.f;
#pragma unroll 16
        for (int j = 0; j < 64; ++j) s += ((const float*)(a.ws + WS_B1P))[(size_t)(job * 64 + j) * 256 + F.tid];
        B1[F.tid] = s; }
    __syncthreads();
#pragma unroll 4
    for (int e = F.tid; e < 32 * 256; e += NTHR) { const int rr = e >> 8, cidx = e & 255; float s = B1[cidx];
#pragma unroll
        for (int ks = 0; ks < 8; ++ks) s += P[((size_t)(job * 8 + ks) * 2048 + r0 + rr) * 256 + cidx];
        HID[rr * 257 + cidx] = silu_fast(s); }
    __syncthreads();
    { const float* w2 = a.in[job ? 16 : 13];
        const int lane = F.lane, r32 = lane & 31, h = lane >> 5, nt = F.wave & 3, kh = F.wave >> 2;
        const int o = 32 * nt + r32, dsrc = job ? o : dperm(o);
        f32x16 acc;
#pragma unroll
        for (int r = 0; r < 16; ++r) acc[r] = 0.f;
#pragma unroll 1
        for (int s0 = 0; s0 < 64; s0 += 32) { float bv[32];
#pragma unroll
            for (int u = 0; u < 32; ++u) bv[u] = w2[(size_t)(128 * kh + 2 * (s0 + u) + h) * 128 + dsrc];
#pragma unroll
            for (int u = 0; u < 32; ++u) { const float av = HID[r32 * 257 + 128 * kh + 2 * (s0 + u) + h]; acc = __builtin_amdgcn_mfma_f32_32x32x2f32(av, bv[u], acc, 0, 0, 0); } }
        if (kh == 1) {
#pragma unroll
            for (int r = 0; r < 16; ++r) RED[(nt * 16 + r) * 64 + lane] = acc[r]; }
        __syncthreads();
        if (kh == 0) {
#pragma unroll
            for (int r = 0; r < 16; ++r) { const int row = r0 + crow(r, h), bg = row >> 9, n = row & 511; const float sv = (n == 511) ? 0.f : acc[r] + RED[(nt * 16 + r) * 64 + lane];
                if (job == 0) ((bf16_t*)(a.ws + WS_KC))[((size_t)bg * 512 + n) * 128 + o] = (bf16_t)f2bf(sv);
                else ((bf16_t*)(a.ws + WS_VCT))[((size_t)bg * 128 + o) * 512 + n] = (bf16_t)f2bf(sv); } }
    }
    __syncthreads();
}
DI unsigned queue_next(const Frame& F, unsigned* ctr) {
    __syncthreads();
    if (F.tid == 0) *(LAS unsigned*)(F.lds + NL_QI) = __hip_atomic_fetch_add(ctr, 1u, __ATOMIC_RELAXED, __HIP_MEMORY_SCOPE_AGENT);
    __syncthreads();
    return *(LAS unsigned*)(F.lds + NL_QI);
}
__global__ void __launch_bounds__(NTHR, 2) trunk_fwd(Args args_unused) {
    extern __shared__ __attribute__((aligned(16))) unsigned char lds_raw[];
    Frame F;
    F.lds = (LAS unsigned char*)lds_raw;
    F.tid = threadIdx.x; F.lane = F.tid & 63; F.wave = __builtin_amdgcn_readfirstlane(F.tid >> 6);
    F.G = gridDim.x; F.bid = blockIdx.x;
    volatile LAS unsigned* MISC = (volatile LAS unsigned*)(F.lds + MISC_OFF);
    CArgs* ap0 = (CArgs*)__builtin_amdgcn_kernarg_segment_ptr();
    unsigned* ctl = (unsigned*)(ap0->ws + WS_CTL);
    for (int u = F.tid; u < (LDS_BYTES - LDSCTL_OFF) / 4; u += NTHR) ((LAS unsigned*)(F.lds + LDSCTL_OFF))[u] = 0u;
    __syncthreads();
    XcdBarrier bar = xcd_barrier_post(ctl + CW_BAR, MISC + 8);
#if PROF_BID >= 0
    prof_lap(F.lds, ap0->ws, 99);
#endif
    const int lo = ap0->ph_lo, hi = ap0->ph_hi; int pcount_ = 0; (void)pcount_;
#ifdef ONLY
#define IN(k) ((k) == ONLY && lo <= (k) && (k) < hi)
#else
#define IN(k) (lo <= (k) && (k) < hi)
#endif
#if PROF_BID >= 0
#define GRID_BAR() do { xcd_barrier(bar); prof_lap(F.lds, ws, 100 + (pcount_++)); } while (0)
#else
#define GRID_BAR() xcd_barrier(bar)
#endif
#ifndef PROBE_DUP
#define PROBE_DUP -1
#endif
#define REP(k) for (int rep_ = 0; rep_ < ((k) == PROBE_DUP ? 2 : 1); ++rep_)
#define PHASE_ARGS() CArgs* ap = ap0; asm volatile("" : "+s"(ap)); CArgs& args = *ap; unsigned char* ws = args.ws; (void)ws
    if (IN(0)) REP(0) { PHASE_ARGS(); p0_prologue(F, args); GRID_BAR(); }
    if (IN(1)) REP(1) { PHASE_ARGS(); p1_prenorm0(F, args); p0_weights(F, args, 0, F.bid * NWAVES + F.wave, F.G * NWAVES); GRID_BAR(); }
    if (IN(2)) REP(2) { PHASE_ARGS();
        pg8::Gemm g; g.A[0] = (const bf16_t*)(ws + WS_HY); g.Bt[0] = (const bf16_t*)(ws + WS_WN0); g.nM[0] = MTOK / 256; g.nN[0] = NN0 / 256; g.nK[0] = 1;
        g.A[1] = (const bf16_t*)(ws + WS_WT0); g.Bt[1] = (const bf16_t*)(ws + WS_HY); g.nM[1] = NT0 / 256; g.nN[1] = MTOK / 256; g.nK[1] = 1; g.lda = DM; g.ldb = DM; g.Klen = DM; g.chain = 0;
        pg8::MultiOrder S; S.init(g, F.G, F.bid); EpiProj<0> E{ws};
        pg8::gemm_phase<EpiProj<0>>(F.lds, g, S, E);
        { const int ntile = (MTOK / 256) * (NN0 / 256) + (NT0 / 256) * (MTOK / 256), nfull = ntile % F.G;
          if (nfull > 0 && F.bid >= nfull) p0_weights(F, args, 1, (F.bid - nfull) * NWAVES + F.wave, (F.G - nfull) * NWAVES);
          else if (nfull == 0) p0_weights(F, args, 1, F.bid * NWAVES + F.wave, F.G * NWAVES); }
        GRID_BAR();
    }
    if (IN(3)) REP(3) { PHASE_ARGS();
        const int half = F.G / 2;
        if (F.bid >= half) {
            pg8::Gemm g; g.A[0] = (const bf16_t*)(ws + WS_ACT + A0_NKC); g.Bt[0] = (const bf16_t*)(ws + WS_W1K); g.nM[0] = 8; g.nN[0] = 1; g.nK[0] = 8;
            g.A[1] = (const bf16_t*)(ws + WS_ACT + A0_NVC); g.Bt[1] = (const bf16_t*)(ws + WS_W1V); g.nM[1] = 8; g.nN[1] = 1; g.nK[1] = 8; g.lda = 2048; g.ldb = 4096; g.Klen = 512; g.chain = 0;
            pg8::MultiOrder S; S.init(g, F.G - half, F.bid - half); EpiF32Part E{(float*)(ws + WS_CONCAT)};
            pg8::gemm_phase<EpiF32Part>(F.lds, g, S, E);
        }
        unsigned* qctr = (unsigned*)(ws + WS_CTL) + 2048 + 128 + 64 * rep_;
        for (;;) { const unsigned idx = queue_next(F, qctr); if (idx >= 1024u) break; la_prep<0>(F, args, (int)idx); }
        GRID_BAR();
    }
    if (IN(4)) REP(4) { PHASE_ARGS();
        const int half = F.G / 2;
        if (F.bid < half) la_phase<0, 0>(F, args, F.bid, half);
        else for (int it = F.bid - half; it < 128; it += F.G - half) nsa_compress_finish_item(F, args, it);
        unsigned* qctr = (unsigned*)(ws + WS_CTL) + 2048 + 256 + 64 * rep_;
        for (;;) { const unsigned idx = queue_next(F, qctr); if (idx >= 512u) break; nsa_win_item(F, args, 511 - (int)idx); }
        GRID_BAR();
    }
    if (IN(5)) REP(5) { PHASE_ARGS();
        const int half = F.G / 2;
        for (int r2 = 0; r2 < (PROBE_DUP == 50 ? 2 : 1); ++r2) if (F.bid < half) la_phase<0, 1>(F, args, F.bid, half);
        for (int r2 = 0; r2 < (PROBE_DUP == 51 ? 2 : 1); ++r2) {
        unsigned* qctr = (unsigned*)(ws + WS_CTL) + 2048 + 64 * rep_ + 512 * r2;
        for (;;) { const unsigned idx = queue_next(F, qctr); if (idx >= 512u) break; nsa_main_item(F, args, (127 - (int)(idx >> 2)) * 4 + (int)(idx & 3u)); }
        }
        GRID_BAR();
    }
    if (IN(6)) REP(6) { PHASE_ARGS();
        pg8::Gemm g; g.A[0] = (const bf16_t*)(ws + WS_CONCAT); g.Bt[0] = (const bf16_t*)(ws + WS_WO0); g.nM[0] = MTOK / 256; g.nN[0] = DM / 256; g.nK[0] = 1;
        g.A[1] = nullptr; g.Bt[1] = nullptr; g.nM[1] = 0; g.nN[1] = 0; g.nK[1] = 1; g.lda = DM; g.ldb = DM; g.Klen = DM; g.chain = 0;
        pg8::MultiOrder S; S.init(g, F.G, F.bid); EpiBf16 E{(bf16_t*)(ws + WS_HY), DM};
        pg8::gemm_phase<EpiBf16>(F.lds, g, S, E);
        GRID_BAR();
    }
    if (IN(7)) REP(7) { PHASE_ARGS(); p_residual<0>(F, args); GRID_BAR(); }
    if (IN(8)) REP(8) { PHASE_ARGS();
        pg8::Gemm g; g.A[0] = (const bf16_t*)(ws + WS_HY); g.Bt[0] = (const bf16_t*)(ws + WS_WN1); g.nM[0] = MTOK / 256; g.nN[0] = NN1 / 256; g.nK[0] = 1;
        g.A[1] = (const bf16_t*)(ws + WS_WT1); g.Bt[1] = (const bf16_t*)(ws + WS_HY); g.nM[1] = NT1 / 256; g.nN[1] = MTOK / 256; g.nK[1] = 1; g.lda = DM; g.ldb = DM; g.Klen = DM; g.chain = 0;
        pg8::MultiOrder S; S.init(g, F.G, F.bid); EpiProj<1> E{ws};
        pg8::gemm_phase<EpiProj<1>>(F.lds, g, S, E);
        { const int ntile = (MTOK / 256) * (NN1 / 256) + (NT1 / 256) * (MTOK / 256), nfull = ntile % F.G;
          if (nfull > 0 && F.bid >= nfull) p0_weights(F, args, 2, (F.bid - nfull) * NWAVES + F.wave, (F.G - nfull) * NWAVES);
          else if (nfull == 0) p0_weights(F, args, 2, F.bid * NWAVES + F.wave, F.G * NWAVES); }
        GRID_BAR();
    }
    if (IN(9)) REP(9) { PHASE_ARGS();
        ssd_prep(F, args);
        hgrn_prep_cols(F, args);
        GRID_BAR();
    }
    if (IN(10)) REP(10) { PHASE_ARGS();
        const int half = F.G / 2;
        if (F.bid < half) la_phase<1, 0>(F, args, F.bid, half); else la_phase<2, 0>(F, args, F.bid - half, F.G - half);
        GRID_BAR();
    }
    if (IN(11)) REP(11) { PHASE_ARGS();
        for (int it = F.bid; it < 128; it += F.G) { const int m = it >> 6, bh = (it >> 3) & 7, wsl = it & 7; if (m == 0) la_scan_item<1>(F, args, bh, wsl); else la_scan_item<2>(F, args, bh, wsl); }
        GRID_BAR();
    }
    if (IN(12)) REP(12) { PHASE_ARGS();
        const int half = F.G / 2;
#if !defined(SKIP_H)
        if (F.bid < half) la_phase<1, 1, true>(F, args, F.bid, half);
#endif
#if !defined(SKIP_S)
        if (F.bid >= half) la_phase<2, 1, true>(F, args, F.bid - half, F.G - half);
#endif
        GRID_BAR();
    }
    if (IN(13)) REP(13) { PHASE_ARGS();
        pg8::Gemm g; g.A[0] = (const bf16_t*)(ws + WS_CONCAT); g.Bt[0] = (const bf16_t*)(ws + WS_WO1); g.nM[0] = MTOK / 256; g.nN[0] = DM / 256; g.nK[0] = 2;
        g.A[1] = nullptr; g.Bt[1] = nullptr; g.nM[1] = 0; g.nN[1] = 0; g.nK[1] = 1; g.lda = DM; g.ldb = DM; g.Klen = DM / 2; g.chain = 1;
        pg8::MultiOrder S; S.init(g, F.G, F.bid); EpiBf16Mid E{(bf16_t*)(ws + WS_HY), DM, (const float*)(ws + WS_RTAB)};
        { pg8::Unit u; for (int i = 0; S.next(i, u); ++i) if (F.tid < 256) { const int row = u.pm * 256 + F.tid; const f32x4* p = (const f32x4*)((const float*)(ws + WS_SSQ) + (size_t)row * 16);
                const f32x4 q0 = p[0], q1 = p[1], q2 = p[2], q3 = p[3];
                const float s = ((q0[0] + q0[1]) + (q0[2] + q0[3])) + ((q1[0] + q1[1]) + (q1[2] + q1[3])) + ((q2[0] + q2[1]) + (q2[2] + q2[3])) + ((q3[0] + q3[1]) + (q3[2] + q3[3]));
                ((float*)(ws + WS_RTAB))[row] = 1.0f / sqrtf(s * (1.0f / 1024.0f) + EPS); }
          asm volatile("s_waitcnt vmcnt(0)" ::: "memory"); __syncthreads(); }
        pg8::gemm_phase<EpiBf16Mid>(F.lds, g, S, E);
        GRID_BAR();
    }
    if (IN(14)) REP(14) { PHASE_ARGS(); p_residual<1>(F, args);
#if PROF_BID >= 0
        __syncthreads(); prof_lap(F.lds, ws, 114);
        if (F.bid == 0 && F.tid == 0) { const unsigned long long* ts = (const unsigned long long*)(ws + 32768);
#ifdef PROF_CAL
            args.out[0] = 1000.f * 500.f; args.out[1] = 1000.f * 250.f;
#else
            args.out[0] += (float)ts[PROF_A] * 0.01f * PROF_SCALE; args.out[1] += (float)ts[PROF_B] * 0.01f * PROF_SCALE;
#endif
        }
#endif
    }
#undef IN
#undef GRID_BAR
}

extern "C" void kernel_launch(void* const* d_in, const int* in_sizes, int n_in, void* d_out, int out_size, void* d_ws, size_t ws_size, hipStream_t stream) {
    static int grid = 0;
    if (grid == 0) {
        if (n_in != 27 || out_size != MTOK * DM || ws_size < WS_END) { fprintf(stderr, "kernel_launch: unexpected shapes (n_in %d, out %d, ws %zu < %zu)\n", n_in, out_size, ws_size, (size_t)WS_END); grid = -1; return; }
        int dev = 0, cus = 0;
        if (hipGetDevice(&dev) != hipSuccess || hipDeviceGetAttribute(&cus, hipDeviceAttributeMultiprocessorCount, dev) != hipSuccess) { grid = -1; return; }
        if (hipFuncSetAttribute((const void*)trunk_fwd, hipFuncAttributeMaxDynamicSharedMemorySize, LDS_BYTES) != hipSuccess) { fprintf(stderr, "kernel_launch: hipFuncSetAttribute failed\n"); grid = -1; return; }
        (void)hipGetLastError();
        grid = cus;
    }
    if (grid < 0) return;
    if (hipMemsetAsync((char*)d_ws + WS_CTL, 0, CTL_ZERO_BYTES, stream) != hipSuccess) return;
    Args a{};
    for (int i = 0; i < 27; ++i) a.in[i] = (const float*)d_in[i];
    a.out = (float*)d_out; a.ws = (unsigned char*)d_ws; a.ph_lo = 0; a.ph_hi = 15;
    hipLaunchKernelGGL(trunk_fwd, dim3(grid), dim3(NTHR), LDS_BYTES, stream, a);
}
```
